# Optimizing an MI355X kernel written in HIP

```python
import functools
import jax, jax.numpy as jnp
from jax import lax
import numpy as np

D_MODEL = 2048
BATCH = 4
SEQ = 8192
DEPTH = 2
DEC_BATCH = 8
DEC_SEQ = 16
PAST_LEN = 4096

CHUNK = 64
N_HEADS = 12
N_KV_HEADS = 4
HEAD_DIM = 128
GROUP = N_HEADS // N_KV_HEADS
N_MEM = 256
N_MEM_HEADS = 4
IDX_HEADS = 8
IDX_DIM = 64
TOPK_MAX = 256
BAND_CHUNKS = 8
WIN_B = BAND_CHUNKS * CHUNK
REL_CLIP = 128
D_FF = 5632
ROPE_THETA = 10000.0
LN_EPS = 1e-5
ALPHA = (2 * DEPTH) ** 0.25
BETA = (8 * DEPTH) ** -0.25
N_A_LAYERS = (DEPTH + 1) // 2
N_B_LAYERS = DEPTH // 2
Q_W = N_HEADS * HEAD_DIM
KV_W = N_KV_HEADS * HEAD_DIM
MQ_W = N_MEM_HEADS * HEAD_DIM
IDXQ_W = IDX_HEADS * IDX_DIM
PROJ_A = Q_W + 2 * KV_W + MQ_W + IDXQ_W + IDX_DIM + IDX_HEADS
PROJ_B = Q_W + 2 * KV_W + MQ_W
O_W = Q_W + MQ_W
SPLIT_A = tuple(int(c) for c in np.cumsum([Q_W, KV_W, KV_W, MQ_W, IDXQ_W, IDX_DIM]))
SPLIT_B = tuple(int(c) for c in np.cumsum([Q_W, KV_W, KV_W]))
ATTN_SCALE = HEAD_DIM ** -0.5
IDX_W_SCALE = (IDX_HEADS * IDX_DIM) ** -0.5
NEG_INF = -1e30

kernel_name = 'hybrid_streaming_dsa_chunkband'


def layer_norm(x, g, b):
    xf = x.astype(jnp.float32)
    mu = xf.mean(-1, keepdims=True)
    var = jnp.square(xf - mu).mean(-1, keepdims=True)
    return ((xf - mu) * lax.rsqrt(var + LN_EPS)).astype(x.dtype) * g + b


def rope(x, pos):
    half = x.shape[-1] // 2
    inv_freq = ROPE_THETA ** (-jnp.arange(half, dtype=jnp.float32) / half)
    ang = pos.astype(jnp.float32)[:, None] * inv_freq[None, :]
    cos, sin = jnp.cos(ang)[:, None, :], jnp.sin(ang)[:, None, :]
    xf = x.astype(jnp.float32)
    x1, x2 = xf[..., :half], xf[..., half:]
    return jnp.concatenate([x1 * cos - x2 * sin, x2 * cos + x1 * sin], -1).astype(x.dtype)


def swiglu(x, w_in, w_out):
    g, u = jnp.split(x @ w_in, 2, axis=-1)
    return (jax.nn.silu(g) * u) @ w_out


def mem_attend(qm, mk, mv):
    s = jnp.einsum('bthd,bmhd->bhtm', qm, mk).astype(jnp.float32) * ATTN_SCALE
    p = jax.nn.softmax(s, axis=-1).astype(mv.dtype)
    return jnp.einsum('bhtm,bmhd->bthd', p, mv)


def dsa_attend(q, qi, wi, k, v, ki, q_pos, k_pos, topk):
    B, T = q.shape[:2]
    qb = min(128, T)
    nb = T // qb
    k_chunk = k_pos // CHUNK
    gather = jax.vmap(lambda a, idx: a[idx])
    kif = ki.astype(jnp.float32)

    def split(a):
        return a.reshape((B, nb, qb) + a.shape[2:]).swapaxes(0, 1)

    def block(args):
        qbk, qib, wib, qpos = args
        q_chunk = qpos // CHUNK
        adm = k_chunk[None, :] <= q_chunk[:, None]
        rel = jax.nn.relu(jnp.einsum('bqhd,bsd->bqhs', qib.astype(jnp.float32), kif))
        idx_score = jnp.einsum('bqh,bqhs->bqs', wib.astype(jnp.float32) * IDX_W_SCALE, rel)
        idx_score = jnp.where(adm[None], idx_score, NEG_INF)
        _, sel = lax.top_k(idx_score, topk)
        valid = jnp.take(k_chunk, sel) <= q_chunk[None, :, None]
        ks = gather(k, sel)
        vs = gather(v, sel)
        qg = qbk.reshape(B, qb, N_KV_HEADS, GROUP, HEAD_DIM)
        s = jnp.einsum('bqgrd,bqkgd->bqgrk', qg, ks).astype(jnp.float32) * ATTN_SCALE
        s = jnp.where(valid[:, :, None, None, :], s, NEG_INF)
        p = jax.nn.softmax(s, axis=-1).astype(vs.dtype)
        o = jnp.einsum('bqgrk,bqkgd->bqgrd', p, vs)
        return o.reshape(B, qb, N_HEADS, HEAD_DIM)

    out = lax.map(block, (split(q), split(qi), split(wi), q_pos.reshape(nb, qb)))
    return out.swapaxes(0, 1).reshape(B, T, N_HEADS, HEAD_DIM)


def band_attend(q, k_full, v_full, rel_bias, q_pos, k_pos):
    B, T = q.shape[:2]
    P = k_full.shape[1] - T
    qc = min(CHUNK, T)
    nc = T // qc
    band = P + qc

    def block(c):
        qs = lax.dynamic_slice_in_dim(q, c * qc, qc, axis=1)
        ks = lax.dynamic_slice_in_dim(k_full, c * qc, band, axis=1)
        vs = lax.dynamic_slice_in_dim(v_full, c * qc, band, axis=1)
        qp = lax.dynamic_slice_in_dim(q_pos, c * qc, qc)
        kp = lax.dynamic_slice_in_dim(k_pos, c * qc, band)
        rel = jnp.clip(qp[:, None] - kp[None, :], -REL_CLIP, REL_CLIP) + REL_CLIP
        bias = rel_bias[:, rel].reshape(N_KV_HEADS, GROUP, qc, band)
        qg = qs.reshape(B, qc, N_KV_HEADS, GROUP, HEAD_DIM)
        s = jnp.einsum('bqgrd,bkgd->bgrqk', qg, ks).astype(jnp.float32) * ATTN_SCALE
        s = s + bias[None].astype(jnp.float32)
        s = jnp.where((kp >= 0)[None, None, None, None, :], s, NEG_INF)
        p = jax.nn.softmax(s, axis=-1).astype(vs.dtype)
        o = jnp.einsum('bgrqk,bkgd->bqgrd', p, vs)
        return o.reshape(B, qc, N_HEADS, HEAD_DIM)

    out = lax.map(block, jnp.arange(nc))
    return out.swapaxes(0, 1).reshape(B, T, N_HEADS, HEAD_DIM)


def mixer_a(x, p0, past, mk, mv, w_in, w_o):
    B, T, _ = x.shape
    pos = p0 + jnp.arange(T)
    q, k, v, qm, qi, ki, wi = jnp.split(x @ w_in, SPLIT_A, axis=-1)
    q = rope(q.reshape(B, T, N_HEADS, HEAD_DIM), pos)
    k = rope(k.reshape(B, T, N_KV_HEADS, HEAD_DIM), pos)
    v = v.reshape(B, T, N_KV_HEADS, HEAD_DIM)
    qi = rope(qi.reshape(B, T, IDX_HEADS, IDX_DIM), pos)
    ki = rope(ki.reshape(B, T, 1, IDX_DIM), pos)[:, :, 0]
    if past is None:
        k_all, v_all, ki_all = k, v, ki
    else:
        k_all = jnp.concatenate([past[0], k], axis=1)
        v_all = jnp.concatenate([past[1], v], axis=1)
        ki_all = jnp.concatenate([past[2], ki], axis=1)
    L = k_all.shape[1]
    topk = min(TOPK_MAX, L // 4)
    o = dsa_attend(q, qi, wi, k_all, v_all, ki_all, pos, jnp.arange(L), topk)
    om = mem_attend(qm.reshape(B, T, N_MEM_HEADS, HEAD_DIM), mk, mv)
    y = jnp.concatenate([o.reshape(B, T, Q_W), om.reshape(B, T, MQ_W)], axis=-1) @ w_o
    return y, (k, v, ki)


def mixer_b(x, p0, past, mk, mv, w_in, w_o, rel_bias):
    B, T, _ = x.shape
    pos = p0 + jnp.arange(T)
    q, k, v, qm = jnp.split(x @ w_in, SPLIT_B, axis=-1)
    q = q.reshape(B, T, N_HEADS, HEAD_DIM)
    k = k.reshape(B, T, N_KV_HEADS, HEAD_DIM)
    v = v.reshape(B, T, N_KV_HEADS, HEAD_DIM)
    if past is None:
        pk = jnp.zeros((B, WIN_B, N_KV_HEADS, HEAD_DIM), x.dtype)
        pv = pk
    else:
        pk, pv = past
    P = pk.shape[1]
    k_all = jnp.concatenate([pk, k], axis=1)
    v_all = jnp.concatenate([pv, v], axis=1)
    k_pos = jnp.arange(P + T) + (p0 - P)
    o = band_attend(q, k_all, v_all, rel_bias, pos, k_pos)
    om = mem_attend(qm.reshape(B, T, N_MEM_HEADS, HEAD_DIM), mk, mv)
    y = jnp.concatenate([o.reshape(B, T, Q_W), om.reshape(B, T, MQ_W)], axis=-1) @ w_o
    if past is None:
        n_keep = min(WIN_B, T)
        new_state = (k[:, T - n_keep:], v[:, T - n_keep:])
    else:
        new_state = (k_all[:, T:], v_all[:, T:])
    return y, new_state


def macaron_layer(x, mixer, w1_in, w1_out, w2_in, w2_out, g, b):
    x = layer_norm(ALPHA * x + 0.5 * swiglu(x, w1_in, w1_out), g[0], b[0])
    y, new_state = mixer(x)
    x = layer_norm(ALPHA * x + y, g[1], b[1])
    x = layer_norm(ALPHA * x + 0.5 * swiglu(x, w2_in, w2_out), g[2], b[2])
    return x, new_state


def setup_inputs(seed: int = 0) -> dict:
    key = jax.random.key(seed)
    ks = jax.random.split(key, 22)
    b_buf = min(WIN_B, PAST_LEN)

    def nrm(k, shape, scale):
        return jax.random.normal(k, shape, jnp.float32) * scale

    return {
        'x_prompt': nrm(ks[0], (BATCH, SEQ, D_MODEL), 1.0),
        'x_sample': nrm(ks[1], (DEC_BATCH, DEC_SEQ, D_MODEL), 1.0),
        'mem_prompt': nrm(ks[2], (BATCH, N_MEM, D_MODEL), 1.0),
        'cache_a_k': nrm(ks[3], (N_A_LAYERS, DEC_BATCH, PAST_LEN, N_KV_HEADS, HEAD_DIM), 1.0),
        'cache_a_v': nrm(ks[4], (N_A_LAYERS, DEC_BATCH, PAST_LEN, N_KV_HEADS, HEAD_DIM), 1.0),
        'cache_a_kidx': nrm(ks[5], (N_A_LAYERS, DEC_BATCH, PAST_LEN, IDX_DIM), 1.0),
        'cache_b_k': nrm(ks[6], (N_B_LAYERS, DEC_BATCH, b_buf, N_KV_HEADS, HEAD_DIM), 1.0),
        'cache_b_v': nrm(ks[7], (N_B_LAYERS, DEC_BATCH, b_buf, N_KV_HEADS, HEAD_DIM), 1.0),
        'cache_mem_k': nrm(ks[8], (DEPTH, DEC_BATCH, N_MEM, N_MEM_HEADS, HEAD_DIM), 1.0),
        'cache_mem_v': nrm(ks[9], (DEPTH, DEC_BATCH, N_MEM, N_MEM_HEADS, HEAD_DIM), 1.0),
        'w_in_a': nrm(ks[10], (N_A_LAYERS, D_MODEL, PROJ_A), D_MODEL ** -0.5),
        'w_in_b': nrm(ks[11], (N_B_LAYERS, D_MODEL, PROJ_B), D_MODEL ** -0.5),
        'w_o': nrm(ks[12], (DEPTH, O_W, D_MODEL), BETA * O_W ** -0.5),
        'rel_bias': nrm(ks[13], (N_B_LAYERS, N_HEADS, 2 * REL_CLIP + 1), 0.5),
        'w_mem_kv': nrm(ks[14], (DEPTH, D_MODEL, 2 * MQ_W), D_MODEL ** -0.5),
        'w_ffn1_in': nrm(ks[15], (DEPTH, D_MODEL, 2 * D_FF), D_MODEL ** -0.5),
        'w_ffn1_out': nrm(ks[16], (DEPTH, D_FF, D_MODEL), BETA * D_FF ** -0.5),
        'w_ffn2_in': nrm(ks[17], (DEPTH, D_MODEL, 2 * D_FF), D_MODEL ** -0.5),
        'w_ffn2_out': nrm(ks[18], (DEPTH, D_FF, D_MODEL), BETA * D_FF ** -0.5),
        'ln_g': 1.0 + nrm(ks[19], (DEPTH, 3, D_MODEL), 0.02),
        'ln_b': nrm(ks[20], (DEPTH, 3, D_MODEL), 0.02),
    }


def reference(x_prompt, x_sample, mem_prompt, cache_a_k, cache_a_v, cache_a_kidx,
              cache_b_k, cache_b_v, cache_mem_k, cache_mem_v,
              w_in_a, w_in_b, w_o, rel_bias, w_mem_kv,
              w_ffn1_in, w_ffn1_out, w_ffn2_in, w_ffn2_out, ln_g, ln_b):
    past_len = cache_a_k.shape[2]
    bp = mem_prompt.shape[0]
    mem_kv = jnp.einsum('bmd,ldc->lbmc', mem_prompt, w_mem_kv)
    mk_p, mv_p = jnp.split(mem_kv, 2, axis=-1)
    mk_p = mk_p.reshape(DEPTH, bp, N_MEM, N_MEM_HEADS, HEAD_DIM)
    mv_p = mv_p.reshape(DEPTH, bp, N_MEM, N_MEM_HEADS, HEAD_DIM)
    xp, xs = x_prompt, x_sample
    st_a_p, st_b_p, st_a_s, st_b_s = [], [], [], []
    for i in range(DEPTH):
        j = i // 2
        ffn = (w_ffn1_in[i], w_ffn1_out[i], w_ffn2_in[i], w_ffn2_out[i], ln_g[i], ln_b[i])
        if i % 2 == 0:
            mix_p = functools.partial(mixer_a, p0=0, past=None, mk=mk_p[i], mv=mv_p[i],
                                      w_in=w_in_a[j], w_o=w_o[i])
            mix_s = functools.partial(mixer_a, p0=past_len,
                                      past=(cache_a_k[j], cache_a_v[j], cache_a_kidx[j]),
                                      mk=cache_mem_k[i], mv=cache_mem_v[i], w_in=w_in_a[j], w_o=w_o[i])
            xp, sp = macaron_layer(xp, mix_p, *ffn)
            xs, ss = macaron_layer(xs, mix_s, *ffn)
            st_a_p.append(sp)
            st_a_s.append(ss)
        else:
            mix_p = functools.partial(mixer_b, p0=0, past=None, mk=mk_p[i], mv=mv_p[i],
                                      w_in=w_in_b[j], w_o=w_o[i], rel_bias=rel_bias[j])
            mix_s = functools.partial(mixer_b, p0=past_len, past=(cache_b_k[j], cache_b_v[j]),
                                      mk=cache_mem_k[i], mv=cache_mem_v[i], w_in=w_in_b[j], w_o=w_o[i],
                                      rel_bias=rel_bias[j])
            xp, sp = macaron_layer(xp, mix_p, *ffn)
            xs, ss = macaron_layer(xs, mix_s, *ffn)
            st_b_p.append(sp)
            st_b_s.append(ss)
    new_a_k_prompt = jnp.stack([s[0] for s in st_a_p])
    new_a_v_prompt = jnp.stack([s[1] for s in st_a_p])
    new_a_kidx_prompt = jnp.stack([s[2] for s in st_a_p])
    new_b_k_prompt = jnp.stack([s[0] for s in st_b_p])
    new_b_v_prompt = jnp.stack([s[1] for s in st_b_p])
    new_a_k_sample = jnp.stack([s[0] for s in st_a_s])
    new_a_v_sample = jnp.stack([s[1] for s in st_a_s])
    new_a_kidx_sample = jnp.stack([s[2] for s in st_a_s])
    new_b_k_sample = jnp.stack([s[0] for s in st_b_s])
    new_b_v_sample = jnp.stack([s[1] for s in st_b_s])
    return (xp, xs,
            new_a_k_prompt, new_a_v_prompt, new_a_kidx_prompt,
            new_b_k_prompt, new_b_v_prompt, mk_p, mv_p,
            new_a_k_sample, new_a_v_sample, new_a_kidx_sample,
            new_b_k_sample, new_b_v_sample)
```

```cpp
#include <hip/hip_runtime.h>
#include <cstdio>
#include <cstdint>

#define GAS __attribute__((address_space(1)))
#define LAS __attribute__((address_space(3)))
typedef unsigned short bf16;
typedef short bf16x8 __attribute__((ext_vector_type(8)));
typedef short s16x4 __attribute__((ext_vector_type(4)));
typedef float f32x2 __attribute__((ext_vector_type(2)));
typedef float f32x4 __attribute__((ext_vector_type(4)));
typedef float f32x8 __attribute__((ext_vector_type(8)));
typedef float f32x16 __attribute__((ext_vector_type(16)));
typedef unsigned u32x2 __attribute__((ext_vector_type(2)));
typedef unsigned u32x4 __attribute__((ext_vector_type(4)));

constexpr int DM = 2048, NB = 4, SEQ = 8192, DB = 8, DS = 16, PAST = 4096, BBUF = 512, NMEM = 256;
constexpr int MP = NB * SEQ;
constexpr int MS = DB * DS;
constexpr int MR = MP + MS;
constexpr int MPAD = 33024;
constexpr int DFF = 5632, NFF2 = 2 * DFF;
constexpr int NQ = 1536, NKV = 512, NMQ = 512, NIQ = 512, NIK = 64, NIH = 8;
constexpr int PROJ_A = 3656, PROJ_A_PAD = 3840, PROJ_B = 3072;
constexpr float LN_EPS = 1e-5f;
constexpr float ALPHA = 1.41421356237309515f;
constexpr float ATT_SCALE = 0.088388347648318440f;

constexpr size_t O_YP = 0;
constexpr size_t O_YS = O_YP + (size_t)MP * DM;
constexpr size_t O_AKP = O_YS + (size_t)MS * DM;
constexpr size_t O_AVP = O_AKP + (size_t)MP * 512;
constexpr size_t O_AIP = O_AVP + (size_t)MP * 512;
constexpr size_t O_BKP = O_AIP + (size_t)MP * 64;
constexpr size_t O_BVP = O_BKP + (size_t)NB * 512 * 512;
constexpr size_t O_MK = O_BVP + (size_t)NB * 512 * 512;
constexpr size_t O_MV = O_MK + (size_t)2 * NB * NMEM * 512;
constexpr size_t O_AKS = O_MV + (size_t)2 * NB * NMEM * 512;
constexpr size_t O_AVS = O_AKS + (size_t)MS * 512;
constexpr size_t O_AIS = O_AVS + (size_t)MS * 512;
constexpr size_t O_BKS = O_AIS + (size_t)MS * 64;
constexpr size_t O_BVS = O_BKS + (size_t)DB * 512 * 512;
constexpr size_t O_END = O_BVS + (size_t)DB * 512 * 512;

constexpr size_t MiB = 1u << 20;
constexpr size_t WS_CTL = 0, CTL_ZERO_BYTES = 1 * MiB;
constexpr size_t WS_COS128 = 1 * MiB, WS_SIN128 = 3 * MiB;
constexpr size_t WS_COS64 = 5 * MiB, WS_SIN64 = 6 * MiB;
constexpr size_t WS_MEMB = 7 * MiB;
constexpr size_t WS_MKB = 11 * MiB, WS_MVB = 13 * MiB;
constexpr size_t WS_WFI = 16 * MiB;
constexpr size_t WS_WFO = WS_WFI + 4 * 44 * MiB;
constexpr size_t WS_WINA = WS_WFO + 4 * 22 * MiB;
constexpr size_t WS_WINB = WS_WINA + 15 * MiB;
constexpr size_t WS_WO = WS_WINB + 12 * MiB;
constexpr size_t WS_WMEM = WS_WO + 16 * MiB;
constexpr size_t WS_X = WS_WMEM + 8 * MiB;
constexpr size_t WS_R1 = WS_X + 129 * MiB;
constexpr size_t R1_BYTES = 364 * MiB;
constexpr size_t WS_MASK = WS_R1 + R1_BYTES;
constexpr size_t WS_STATS = WS_MASK + 32 * MiB;
constexpr size_t WS_STATP = WS_STATS + 2 * MiB;
constexpr size_t WS_END = WS_STATP + 16 * MiB;
constexpr size_t R1_Q = 0;
constexpr size_t R1_K = R1_Q + (size_t)MPAD * NQ * 2;
constexpr size_t R1_V = R1_K + (size_t)MPAD * NKV * 2;
constexpr size_t R1_QM = R1_V + (size_t)MPAD * NKV * 2;
constexpr size_t R1_QI = R1_QM + (size_t)MPAD * NMQ * 2;
constexpr size_t R1_KI = R1_QI + (size_t)MPAD * NIQ * 2;
constexpr size_t R1_WI = R1_KI + (size_t)MPAD * NIK * 2;
constexpr size_t R1_AO = R1_WI + (size_t)MPAD * NIH * 4;
static_assert(R1_AO + (size_t)MPAD * DM * 2 <= R1_BYTES && (size_t)MPAD * DFF * 2 <= R1_BYTES, "R1 region");
static_assert(WS_X + (size_t)MPAD * DM * 2 <= WS_R1, "X region");
constexpr int CW_BAR = 4096;
constexpr size_t CTL_CSBW = 65536;
constexpr int CSBW_STRIDE = 2 * NFF2;
static_assert(CTL_CSBW + 5 * CSBW_STRIDE * 4 <= CTL_ZERO_BYTES, "csbw inside the memset region");
enum { FM_F2L0 = 0, FM_F1L1 = 1, FM_F2L1 = 2, FM_INA = 3, FM_INB = 4 };

constexpr int RING_BYTES = 131072 + 8192;
constexpr int LDSCTL_OFF = RING_BYTES, MISC_OFF = LDSCTL_OFF + 320;
constexpr int LDS_BYTES = RING_BYTES + 1024;
constexpr int NWAVES = 8;

__host__ __device__ __forceinline__ size_t ki_tiled(size_t row, int d) { return (row >> 5) * 2048 + (size_t)(((d & 31) >> 3) * 512 + (((d >> 5) * 32) + (int)(row & 31)) * 8 + (d & 7)); }
#define RLX_AGENT __ATOMIC_RELAXED, __HIP_MEMORY_SCOPE_AGENT
#define LDS_WAIT() asm volatile("s_waitcnt lgkmcnt(0)" ::: "memory")
#define VM_WAIT() asm volatile("s_waitcnt vmcnt(0)" ::: "memory")
__device__ __forceinline__ unsigned f2bf(float f) { unsigned u = __builtin_bit_cast(unsigned, f); return (u + 0x7fffu + ((u >> 16) & 1u)) >> 16; }
__device__ __forceinline__ unsigned pk2(float lo, float hi) { return f2bf(lo) | (f2bf(hi) << 16); }
__device__ __forceinline__ float bf2f(unsigned short b) { return __builtin_bit_cast(float, (unsigned)b << 16); }
__device__ __forceinline__ unsigned cvt_pk_bf16(float lo, float hi) { unsigned r; asm volatile("v_cvt_pk_bf16_f32 %0, %1, %2" : "=v"(r) : "v"(lo), "v"(hi)); return r; }
__device__ __forceinline__ float wave_sum(float v) {
#pragma unroll
    for (int o = 1; o < 64; o <<= 1) v += __shfl_xor(v, o);
    return v;
}
__device__ __forceinline__ float wave_max(float v) {
#pragma unroll
    for (int o = 1; o < 64; o <<= 1) v = fmaxf(v, __shfl_xor(v, o));
    return v;
}

#define XB_TMO      128
#define XB_XCNT(j)  (256  + 64 * (j))
#define XB_XSUB(j)  (1280 + 64 * (j))
#define XB_XGEN(j)  (2304 + 64 * (j))
#define XB_TOP      3328
#define XB_TOPGEN   3392
#define XCD_BAR_WORDS 3456
#define XB_SPIN_CAP (1u << 18)

__device__ __forceinline__ unsigned xb_ld(unsigned* p)              { return __hip_atomic_load(p, __ATOMIC_RELAXED, __HIP_MEMORY_SCOPE_AGENT); }
__device__ __forceinline__ unsigned xb_add(unsigned* p, unsigned v) { return __hip_atomic_fetch_add(p, v, __ATOMIC_RELAXED, __HIP_MEMORY_SCOPE_AGENT); }
__device__ __forceinline__ unsigned xb_xcc_id() { return (unsigned)__builtin_amdgcn_s_getreg((3 << 11) | 20) & 0xFu; }
#define XB_SPIN(cond, bar) do { unsigned _sp = 0; while (cond) { __builtin_amdgcn_s_sleep(1); \
    if ((++_sp & 255u) == 0u) { if (xb_ld(&(bar)[XB_TMO])) break; if (_sp > XB_SPIN_CAP) { atomicAdd(&(bar)[XB_TMO], 1u); break; } } } } while (0)

struct XcdBarrier {
    unsigned* bar; unsigned x;
    volatile LAS unsigned* st;
};

__device__ __forceinline__ XcdBarrier xcd_barrier_post(unsigned* bar, volatile LAS unsigned* st) {
    XcdBarrier b; b.bar = bar; b.x = xb_xcc_id(); b.st = st;
    if (threadIdx.x == 0) (void)xb_add(&bar[XB_XCNT(b.x)], 1u);
    return b;
}
__device__ __forceinline__ void xcd_barrier_complete(unsigned* bar, unsigned x, unsigned& nloc, unsigned& nx) {
    const unsigned G = gridDim.x * gridDim.y * gridDim.z;
    unsigned sum, cnt, mine, sp = 0u;
    for (;;) {
        sum = 0u; cnt = 0u; mine = 0u;
#pragma unroll
        for (unsigned j = 0; j < 16; ++j) { const unsigned c = xb_ld(&bar[XB_XCNT(j)]); sum += c; cnt += (c > 0u) ? 1u : 0u; mine = (j == x) ? c : mine; }
        if (sum == G) break;
        __builtin_amdgcn_s_sleep(1);
        if ((++sp & 255u) == 0u) { if (xb_ld(&bar[XB_TMO])) break; if (sp > XB_SPIN_CAP) { atomicAdd(&bar[XB_TMO], 1u); break; } }
    }
    nloc = mine > 0u ? mine : 1u; nx = cnt > 0u ? cnt : 1u;
}

__device__ __forceinline__ void xcd_barrier(const XcdBarrier& b) {
    asm volatile("s_waitcnt vmcnt(0)" ::: "memory");
    __syncthreads();
    if (threadIdx.x == 0) {
        unsigned* bar = b.bar;
        __builtin_amdgcn_s_waitcnt(0);
        unsigned nloc = b.st[0], nx = b.st[1];
        if (nloc == 0u) { xcd_barrier_complete(bar, b.x, nloc, nx); b.st[0] = nloc; b.st[1] = nx; }
        const unsigned old = xb_add(&bar[XB_XSUB(b.x)], 1u);
        const unsigned gen = old / nloc;
        if (old + 1u == (gen + 1u) * nloc) {
            __builtin_amdgcn_fence(__ATOMIC_RELEASE, "agent");
            asm volatile("s_waitcnt vmcnt(0)" ::: "memory");
            const unsigned og = xb_add(&bar[XB_TOP], 1u);
            const unsigned tg = og / nx;
            if (og + 1u == (tg + 1u) * nx) xb_add(&bar[XB_TOPGEN], 1u);
            else XB_SPIN(xb_ld(&bar[XB_TOPGEN]) == tg, bar);
            __builtin_amdgcn_fence(__ATOMIC_ACQUIRE, "agent");
            xb_add(&bar[XB_XGEN(b.x)], 1u);
            asm volatile("s_waitcnt vmcnt(0)" ::: "memory");
        } else {
            XB_SPIN(xb_ld(&bar[XB_XGEN(b.x)]) == gen, bar);
            __builtin_amdgcn_fence(__ATOMIC_ACQUIRE, "agent");
            asm volatile("s_waitcnt vmcnt(0)" ::: "memory");
        }
    }
    __syncthreads();
}
namespace pg8 {
#define PG8_LAS __attribute__((address_space(3)))
typedef unsigned short bf16_t;
typedef short bf16x8 __attribute__((ext_vector_type(8)));
typedef float f32x4 __attribute__((ext_vector_type(4)));
typedef unsigned u32x4 __attribute__((ext_vector_type(4)));
constexpr int BM = 256, BK = 64, HALF = 128, HTB = HALF * BK * 2  , STAGE_BYTES = 8 * HTB, NXCD = 8, WGM = 8;

__host__ __device__ __forceinline__ int lds_byte(int r, int c) { const int st = (r >> 4) * 2 + (c >> 5), rr = r & 15, cc = c & 31, ob = rr * 64 + cc * 2; return st * 1024 + (ob ^ (((ob >> 9) & 1) << 5)); }
__host__ __device__ __forceinline__ void stage_rc(int b, int& R, int& C) { const int st = b / 1024, sb = b % 1024, swz = sb ^ (((sb >> 9) & 1) << 5); R = (st >> 1) * 16 + swz / 64; C = (st & 1) * 32 + (swz % 64) / 2; }
__host__ __device__ __forceinline__ int perm32(int rho) { const int n = rho >> 4, i = rho & 15; return 8 * (i >> 2) + 4 * n + (i & 3); }

struct Unit { int pm, pn; };
struct Gemm { const bf16_t* A; const bf16_t* Bt; int M, N, K; };

struct StaticOrder {
    int nM, nN, nwg, G, c;
    __host__ __device__ void init(int M, int N, int G_, int c_) { nM = M / BM; nN = N / BM; nwg = nM * nN; G = G_; c = c_; }
    __host__ __device__ bool next(int i, Unit& u) const {
        const long L = (long)i * G + c; if (L >= nwg) return false;
        int wgid = (int)L; { const int q = nwg / NXCD, r = nwg % NXCD, xcd = wgid % NXCD, off = wgid / NXCD; wgid = (xcd < r ? xcd * (q + 1) : r * (q + 1) + (xcd - r) * q) + off; }
        const int nig = WGM * nN, gid = wgid / nig, fm = gid * WGM, gsz = (nM - fm) < WGM ? (nM - fm) : WGM;
        u.pm = fm + ((wgid % nig) % gsz); u.pn = (wgid % nig) / gsz; return true;
    }
    __device__ __forceinline__ void a_ready(const Unit&) const {}
    __device__ __forceinline__ void done(const Unit&) const {}
};
__device__ __forceinline__ unsigned cvt_pk_bf16(float lo, float hi) { unsigned r; asm volatile("v_cvt_pk_bf16_f32 %0, %1, %2" : "=v"(r) : "v"(lo), "v"(hi)); return r; }
typedef float f32x2 __attribute__((ext_vector_type(2)));

__device__ __forceinline__ u32x4 pack8(const f32x4 a, const f32x4 b) { u32x4 w; w.x = cvt_pk_bf16(a[0], a[1]); w.y = cvt_pk_bf16(a[2], a[3]); w.z = cvt_pk_bf16(b[0], b[1]); w.w = cvt_pk_bf16(b[2], b[3]); return w; }
__device__ __forceinline__ void unpack8(const u32x4 w, f32x4& a, f32x4& b) {
    a[0] = __builtin_bit_cast(float, w.x << 16); a[1] = __builtin_bit_cast(float, w.x & 0xffff0000u); a[2] = __builtin_bit_cast(float, w.y << 16); a[3] = __builtin_bit_cast(float, w.y & 0xffff0000u);
    b[0] = __builtin_bit_cast(float, w.z << 16); b[1] = __builtin_bit_cast(float, w.z & 0xffff0000u); b[2] = __builtin_bit_cast(float, w.w << 16); b[3] = __builtin_bit_cast(float, w.w & 0xffff0000u); }
__device__ __forceinline__ f32x4 silu_mul(const f32x4 g, const f32x4 u) {
    f32x4 r;
#pragma unroll
    for (int i = 0; i < 4; ++i) { const float e = __builtin_amdgcn_exp2f(g[i] * -1.4426950408889634f); r[i] = g[i] * __builtin_amdgcn_rcpf(1.0f + e) * u[i]; }
    return r; }

__device__ __forceinline__ void row_mu_rstd(const float* st, int row, float& mu, float& rstd) { const f32x2 s = *(const GAS f32x2*)(st + 2 * (size_t)row); mu = s[0] * (1.0f / DM); const float var = s[1] * (1.0f / DM) - mu * mu; rstd = __builtin_amdgcn_rsqf(fmaxf(var, 0.f) + LN_EPS); }
__device__ __forceinline__ void ln_fix8(f32x4& a0, f32x4& a1, const float* cb, int n, float mu, float rstd) {
    const f32x4 p0 = *(const f32x4*)(cb + 2 * n), p1 = *(const f32x4*)(cb + 2 * n + 4), p2 = *(const f32x4*)(cb + 2 * n + 8), p3 = *(const f32x4*)(cb + 2 * n + 12);
    a0[0] = rstd * (a0[0] - mu * p0[0]) + p0[1]; a0[1] = rstd * (a0[1] - mu * p0[2]) + p0[3]; a0[2] = rstd * (a0[2] - mu * p1[0]) + p1[1]; a0[3] = rstd * (a0[3] - mu * p1[2]) + p1[3];
    a1[0] = rstd * (a1[0] - mu * p2[0]) + p2[1]; a1[1] = rstd * (a1[1] - mu * p2[2]) + p2[3]; a1[2] = rstd * (a1[2] - mu * p3[0]) + p3[1]; a1[3] = rstd * (a1[3] - mu * p3[2]) + p3[3]; }
__device__ __forceinline__ float sum_fq(float x) {
    { auto r = __builtin_amdgcn_permlane16_swap(__float_as_uint(x), __float_as_uint(x), false, false); x = __uint_as_float(r[0]) + __uint_as_float(r[1]); }
    { auto r = __builtin_amdgcn_permlane32_swap(__float_as_uint(x), __float_as_uint(x), false, false); x = __uint_as_float(r[0]) + __uint_as_float(r[1]); }
    return x; }
struct ColFix { f32x4 p0, p1, p2, p3; };
__device__ __forceinline__ ColFix colfix_load(const float* cb, int n) { ColFix c; c.p0 = *(const GAS f32x4*)(cb + 2 * n); c.p1 = *(const GAS f32x4*)(cb + 2 * n + 4); c.p2 = *(const GAS f32x4*)(cb + 2 * n + 8); c.p3 = *(const GAS f32x4*)(cb + 2 * n + 12); return c; }
__device__ __forceinline__ void colfix_apply(f32x4& a0, f32x4& a1, const ColFix& c, float mu, float rstd) {
    a0[0] = rstd * (a0[0] - mu * c.p0[0]) + c.p0[1]; a0[1] = rstd * (a0[1] - mu * c.p0[2]) + c.p0[3]; a0[2] = rstd * (a0[2] - mu * c.p1[0]) + c.p1[1]; a0[3] = rstd * (a0[3] - mu * c.p1[2]) + c.p1[3];
    a1[0] = rstd * (a1[0] - mu * c.p2[0]) + c.p2[1]; a1[1] = rstd * (a1[1] - mu * c.p2[2]) + c.p2[3]; a1[2] = rstd * (a1[2] - mu * c.p3[0]) + c.p3[1]; a1[3] = rstd * (a1[3] - mu * c.p3[2]) + c.p3[3]; }
__device__ __forceinline__ void stats_to_mu_rstd(const f32x2 s, float& mu, float& rstd) { mu = s[0] * (1.0f / DM); const float var = s[1] * (1.0f / DM) - mu * mu; rstd = __builtin_amdgcn_rsqf(fmaxf(var, 0.f) + LN_EPS); }
struct EpiSwiglu {
    static constexpr bool PERM = true, AFTER_DRAIN = false;
    bf16_t* H; const float* st; const float* cb; int ln;
    __device__ __forceinline__ void operator()(const f32x4 (&acc)[2][2][4][2], const Unit& u, int wr, int wc, int fr, int fq) const {
        asm volatile("" : "+v"(fr), "+v"(fq));
        const int row0 = u.pm * BM + wr * 64 + fr, col0 = u.pn * HALF + wc * 32 + 8 * fq, n0 = u.pn * BM + wc * 32 + 8 * fq;
        f32x2 sr[2][4]; ColFix cg, cu;
        if (ln) { cg = colfix_load(cb, n0); cu = colfix_load(cb, n0 + HALF);
#pragma unroll
            for (int ai = 0; ai < 2; ++ai)
#pragma unroll
                for (int m = 0; m < 4; ++m) sr[ai][m] = *(const GAS f32x2*)(st + 2 * (size_t)(row0 + ai * HALF + m * 16)); }
#pragma unroll
        for (int ai = 0; ai < 2; ++ai)
#pragma unroll
            for (int m = 0; m < 4; ++m) { const int row = row0 + ai * HALF + m * 16;
                bf16_t* p = H + (size_t)row * DFF + col0;
                f32x4 g0 = acc[ai][0][m][0], g1 = acc[ai][0][m][1], u0 = acc[ai][1][m][0], u1 = acc[ai][1][m][1];
                if (ln) { float mu, rstd; stats_to_mu_rstd(sr[ai][m], mu, rstd); colfix_apply(g0, g1, cg, mu, rstd); colfix_apply(u0, u1, cu, mu, rstd); }
                const f32x4 h0 = silu_mul(g0, u0), h1 = silu_mul(g1, u1);
                *(u32x4*)p = pack8(h0, h1); }
    }
};
struct EpiResid {
    static constexpr bool PERM = true, AFTER_DRAIN = false;
    bf16_t* X; float cs; float al; const float* sto; const float* g; const float* b; float* stn; int ln;
    __device__ __forceinline__ void operator()(const f32x4 (&acc)[2][2][4][2], const Unit& u, int wr, int wc, int fr, int fq) const {
        asm volatile("" : "+v"(fr), "+v"(fq));
        const int row0 = u.pm * BM + wr * 64 + fr, col0 = u.pn * BM + wc * 32 + 8 * fq;
        f32x4 gv[2][2], bv[2][2]; f32x2 sr[2][4];
        if (ln) {
#pragma unroll
            for (int bj = 0; bj < 2; ++bj) { gv[bj][0] = *(const GAS f32x4*)(g + col0 + bj * HALF); gv[bj][1] = *(const GAS f32x4*)(g + col0 + bj * HALF + 4); bv[bj][0] = *(const GAS f32x4*)(b + col0 + bj * HALF); bv[bj][1] = *(const GAS f32x4*)(b + col0 + bj * HALF + 4); }
#pragma unroll
            for (int ai = 0; ai < 2; ++ai)
#pragma unroll
                for (int m = 0; m < 4; ++m) sr[ai][m] = *(const GAS f32x2*)(sto + 2 * (size_t)(row0 + ai * HALF + m * 16)); }
#pragma unroll
        for (int am = 0; am < 8; am += 2) {
            u32x4 xin[2][2];
#pragma unroll
            for (int mm = 0; mm < 2; ++mm)
#pragma unroll
                for (int bj = 0; bj < 2; ++bj) xin[mm][bj] = *(const u32x4*)(X + (size_t)(row0 + ((am + mm) >> 2) * HALF + ((am + mm) & 3) * 16) * DM + col0 + bj * HALF);
#pragma unroll
            for (int mm = 0; mm < 2; ++mm) { const int ai = (am + mm) >> 2, m = (am + mm) & 3; const int row = row0 + ai * HALF + m * 16;
                bf16_t* p = X + (size_t)row * DM + col0; float mu = 0.f, rstd = 1.f; if (ln) stats_to_mu_rstd(sr[ai][m], mu, rstd);
                float s1 = 0.f, s2 = 0.f;
#pragma unroll
                for (int bj = 0; bj < 2; ++bj) { f32x4 x0, x1; unpack8(xin[mm][bj], x0, x1);
                    if (ln) { x0 = (x0 - mu) * rstd * gv[bj][0] + bv[bj][0]; x1 = (x1 - mu) * rstd * gv[bj][1] + bv[bj][1]; }
                    const f32x4 v0 = x0 * al + acc[ai][bj][m][0] * cs, v1 = x1 * al + acc[ai][bj][m][1] * cs;
                    s1 += (v0[0] + v0[1]) + (v0[2] + v0[3]) + (v1[0] + v1[1]) + (v1[2] + v1[3]);
                    s2 += (v0[0] * v0[0] + v0[1] * v0[1]) + (v0[2] * v0[2] + v0[3] * v0[3]) + (v1[0] * v1[0] + v1[1] * v1[1]) + (v1[2] * v1[2] + v1[3] * v1[3]);
                    *(u32x4*)(p + bj * HALF) = pack8(v0, v1); }
                s1 += __shfl_xor(s1, 16); s1 += __shfl_xor(s1, 32); s2 += __shfl_xor(s2, 16); s2 += __shfl_xor(s2, 32);
                if (fq == 0) *(GAS f32x2*)(stn + ((size_t)row * 32 + u.pn * 4 + wc) * 2) = (f32x2){s1, s2}; }
        }
    }
};
struct EpiMem {
    static constexpr bool PERM = true, AFTER_DRAIN = false;
    float* omk; float* omv; bf16_t* mkb; bf16_t* mvb;
    __device__ __forceinline__ void operator()(const f32x4 (&acc)[2][2][4][2], const Unit& u, int wr, int wc, int fr, int fq) const {
        const int row0 = u.pm * BM + wr * 64 + fr; const int l = u.pn >> 2, isv = (u.pn >> 1) & 1, cbase = (u.pn & 1) * BM + wc * 32 + 8 * fq;
        float* of = isv ? omv : omk; bf16_t* ob = isv ? mvb : mkb;
#pragma unroll
        for (int ai = 0; ai < 2; ++ai)
#pragma unroll
            for (int m = 0; m < 4; ++m) { const size_t off = ((size_t)l * 1024 + row0 + ai * HALF + m * 16) * 512 + cbase;
#pragma unroll
                for (int bj = 0; bj < 2; ++bj) { *(f32x4*)(of + off + bj * HALF) = acc[ai][bj][m][0]; *(f32x4*)(of + off + bj * HALF + 4) = acc[ai][bj][m][1];
                    *(u32x4*)(ob + off + bj * HALF) = pack8(acc[ai][bj][m][0], acc[ai][bj][m][1]); } }
    }
};
__device__ __forceinline__ int row_pos(int row) { return row < MP ? (row & (SEQ - 1)) : PAST + ((row - MP) & (DS - 1)); }
__device__ __forceinline__ void rope8(const f32x4 a0, const f32x4 a1, const f32x4 b0, const f32x4 b1, const float* ct, const float* st, f32x4& o10, f32x4& o11, f32x4& o20, f32x4& o21) {
    const f32x4 c0 = *(const f32x4*)ct, c1 = *(const f32x4*)(ct + 4), s0 = *(const f32x4*)st, s1 = *(const f32x4*)(st + 4);
    o10 = a0 * c0 - b0 * s0; o11 = a1 * c1 - b1 * s1; o20 = b0 * c0 + a0 * s0; o21 = b1 * c1 + a1 * s1; }
struct EpiInA {
    static constexpr bool PERM = true, AFTER_DRAIN = false;
    unsigned char* ws; float* out; const float* st; const float* cb;
    __device__ __forceinline__ void operator()(const f32x4 (&acc)[2][2][4][2], const Unit& u, int wr, int wc, int fr, int fq) const {
        bf16_t* q = (bf16_t*)(ws + WS_R1 + R1_Q); bf16_t* k = (bf16_t*)(ws + WS_R1 + R1_K); bf16_t* v = (bf16_t*)(ws + WS_R1 + R1_V); bf16_t* qm = (bf16_t*)(ws + WS_R1 + R1_QM);
        bf16_t* qi = (bf16_t*)(ws + WS_R1 + R1_QI); bf16_t* ki = (bf16_t*)(ws + WS_R1 + R1_KI); float* wi = (float*)(ws + WS_R1 + R1_WI);
        const float* c128 = (const float*)(ws + WS_COS128); const float* s128 = (const float*)(ws + WS_SIN128); const float* c64 = (const float*)(ws + WS_COS64); const float* s64 = (const float*)(ws + WS_SIN64);
        asm volatile("" : "+v"(fr), "+v"(fq));
        const int row0 = u.pm * BM + wr * 64 + fr, lc0 = wc * 32 + 8 * fq, pn = u.pn;
        const ColFix ca = colfix_load(cb, pn * BM + lc0), cbf = colfix_load(cb, pn * BM + HALF + lc0);
#pragma unroll
        for (int ai = 0; ai < 2; ++ai) { f32x2 sr[1][4];
#pragma unroll
            for (int m = 0; m < 4; ++m) {
                if ((m & 1) == 0) { sr[0][m] = *(const GAS f32x2*)(st + 2 * (size_t)(row0 + ai * HALF + m * 16)); sr[0][m + 1] = *(const GAS f32x2*)(st + 2 * (size_t)(row0 + ai * HALF + (m + 1) * 16)); }
                const int row = row0 + ai * HALF + m * 16; if (row >= MR) continue;
                const int pos = row_pos(row);
                f32x4 a0 = acc[ai][0][m][0], a1 = acc[ai][0][m][1], b0 = acc[ai][1][m][0], b1 = acc[ai][1][m][1];
                { float mu, rstd; stats_to_mu_rstd(sr[0][m], mu, rstd); colfix_apply(a0, a1, ca, mu, rstd); colfix_apply(b0, b1, cbf, mu, rstd); }
                if (pn < 8) {
                    const int d0 = lc0 & 63; f32x4 o10, o11, o20, o21;
                    rope8(a0, a1, b0, b1, c128 + (size_t)pos * 64 + d0, s128 + (size_t)pos * 64 + d0, o10, o11, o20, o21);
                    if (pn < 6) { bf16_t* p = q + (size_t)row * NQ + (2 * pn + (lc0 >> 6)) * 128 + d0; *(u32x4*)p = pack8(o10, o11); *(u32x4*)(p + 64) = pack8(o20, o21); }
                    else { const int c = (2 * (pn - 6) + (lc0 >> 6)) * 128 + d0; bf16_t* p = k + (size_t)row * NKV + c; *(u32x4*)p = pack8(o10, o11); *(u32x4*)(p + 64) = pack8(o20, o21);
                        float* o = out + (row < MP ? O_AKP + (size_t)row * 512 : O_AKS + (size_t)(row - MP) * 512) + c;
                        *(f32x4*)o = o10; *(f32x4*)(o + 4) = o11; *(f32x4*)(o + 64) = o20; *(f32x4*)(o + 68) = o21; }
                } else if (pn < 10) {
                    const int c = (pn - 8) * BM + lc0; bf16_t* p = v + (size_t)row * NKV + c; *(u32x4*)p = pack8(a0, a1); *(u32x4*)(p + HALF) = pack8(b0, b1);
                    float* o = out + (row < MP ? O_AVP + (size_t)row * 512 : O_AVS + (size_t)(row - MP) * 512) + c;
                    *(f32x4*)o = a0; *(f32x4*)(o + 4) = a1; *(f32x4*)(o + HALF) = b0; *(f32x4*)(o + HALF + 4) = b1;
                } else if (pn < 12) {
                    bf16_t* p = qm + (size_t)row * NMQ + (pn - 10) * BM + lc0; *(u32x4*)p = pack8(a0, a1); *(u32x4*)(p + HALF) = pack8(b0, b1);
                } else if (pn < 14) {
                    const int d0 = 8 * fq; f32x4 o10, o11, o20, o21;
                    rope8(a0, a1, b0, b1, c64 + (size_t)pos * 32 + d0, s64 + (size_t)pos * 32 + d0, o10, o11, o20, o21);
                    bf16_t* p = qi + (size_t)row * NIQ + (4 * (pn - 12) + wc) * 64 + d0; *(u32x4*)p = pack8(o10, o11); *(u32x4*)(p + 32) = pack8(o20, o21);
                } else {
                    if (wc == 0) { const int d0 = 8 * fq; f32x4 o10, o11, o20, o21;
                        rope8(a0, a1, b0, b1, c64 + (size_t)pos * 32 + d0, s64 + (size_t)pos * 32 + d0, o10, o11, o20, o21);
                        bf16_t* p = ki + (size_t)(row >> 5) * 2048 + fq * 512 + (row & 31) * 8; *(u32x4*)p = pack8(o10, o11); *(u32x4*)(p + 256) = pack8(o20, o21);
                        float* o = out + (row < MP ? O_AIP + (size_t)row * 64 : O_AIS + (size_t)(row - MP) * 64) + d0;
                        *(f32x4*)o = o10; *(f32x4*)(o + 4) = o11; *(f32x4*)(o + 32) = o20; *(f32x4*)(o + 36) = o21;
                    } else if (wc == 1 && fq == 0) { float* o = wi + (size_t)row * NIH; *(f32x4*)o = a0; *(f32x4*)(o + 4) = a1; }
                }
                asm volatile("" ::: "memory");
            } }
    }
};
struct EpiInB {
    static constexpr bool PERM = true, AFTER_DRAIN = false;
    unsigned char* ws; float* out; const float* st; const float* cb;
    __device__ __forceinline__ void operator()(const f32x4 (&acc)[2][2][4][2], const Unit& u, int wr, int wc, int fr, int fq) const {
        bf16_t* q = (bf16_t*)(ws + WS_R1 + R1_Q); bf16_t* k = (bf16_t*)(ws + WS_R1 + R1_K); bf16_t* v = (bf16_t*)(ws + WS_R1 + R1_V); bf16_t* qm = (bf16_t*)(ws + WS_R1 + R1_QM);
        asm volatile("" : "+v"(fr), "+v"(fq));
        const int row0 = u.pm * BM + wr * 64 + fr, lc0 = wc * 32 + 8 * fq, pn = u.pn;
        const ColFix ca = colfix_load(cb, pn * BM + lc0), cbf = colfix_load(cb, pn * BM + HALF + lc0);
#pragma unroll
        for (int ai = 0; ai < 2; ++ai) { f32x2 sr[1][4];
#pragma unroll
            for (int m = 0; m < 4; ++m) sr[0][m] = *(const GAS f32x2*)(st + 2 * (size_t)(row0 + ai * HALF + m * 16));
#pragma unroll
            for (int m = 0; m < 4; ++m) {
                const int row = row0 + ai * HALF + m * 16; if (row >= MR) continue;
                f32x4 a0 = acc[ai][0][m][0], a1 = acc[ai][0][m][1], b0 = acc[ai][1][m][0], b1 = acc[ai][1][m][1];
                { float mu, rstd; stats_to_mu_rstd(sr[0][m], mu, rstd); colfix_apply(a0, a1, ca, mu, rstd); colfix_apply(b0, b1, cbf, mu, rstd); }
                if (pn < 6) { bf16_t* p = q + (size_t)row * NQ + pn * BM + lc0; *(u32x4*)p = pack8(a0, a1); *(u32x4*)(p + HALF) = pack8(b0, b1); }
                else if (pn < 10) {
                    const int isv = pn >= 8, c = ((pn - 6) & 1) * BM + lc0; bf16_t* p = (isv ? v : k) + (size_t)row * NKV + c; *(u32x4*)p = pack8(a0, a1); *(u32x4*)(p + HALF) = pack8(b0, b1);
                    float* o = nullptr;
                    if (row < MP) { const int t = row & (SEQ - 1), b = row >> 13; if (t >= SEQ - 512) o = out + (isv ? O_BVP : O_BKP) + ((size_t)b * 512 + (t - (SEQ - 512))) * 512 + c; }
                    else { const int sb = (row - MP) >> 4, st = (row - MP) & 15; o = out + (isv ? O_BVS : O_BKS) + ((size_t)sb * 512 + (BBUF - DS) + st) * 512 + c; }
                    if (o) { *(f32x4*)o = a0; *(f32x4*)(o + 4) = a1; *(f32x4*)(o + HALF) = b0; *(f32x4*)(o + HALF + 4) = b1; }
                } else { bf16_t* p = qm + (size_t)row * NMQ + (pn - 10) * BM + lc0; *(u32x4*)p = pack8(a0, a1); *(u32x4*)(p + HALF) = pack8(b0, b1); }
            } }
    }
};
template <class Epi, class Sched, bool ALIGN_EPI = false, bool SP2 = false>
__device__ __forceinline__ void gemm_phase(PG8_LAS unsigned char* lds, const Gemm g, const Sched& S, const Epi& E) {
    int tid = threadIdx.x; asm volatile("" : "+v"(tid));
    const int wid = __builtin_amdgcn_readfirstlane(tid >> 6), lane = tid & 63, wr = wid >> 2, wc = wid & 3, fr = lane & 15, fq = lane >> 4;
    const int K = g.K, nt = K / BK;
    unsigned voffA[2], voffB[2];
#pragma unroll
    for (int i = 0; i < 2; ++i) { int R, C; stage_rc(tid * 16 + i * 8192, R, C); const int Rb = Epi::PERM ? ((R & ~31) + perm32(R & 31)) : R;
        voffA[i] = (unsigned)(R * K + C) * 2u; voffB[i] = (unsigned)(Rb * K + C) * 2u; }
    const size_t kstep = (size_t)(BK * 2);
    const size_t hstep = (size_t)HALF * K * 2;
    const size_t tstep = 2 * hstep;
    const unsigned ldsw = (unsigned)wid * 1024u;
    const int aoff = lds_byte(wr * 64 + fr, fq * 8), boff = lds_byte(wc * 32 + fr, fq * 8);
#define PG8_SA(b, h) (((b) * 2 + (h)) * HTB)
#define PG8_SB(b, h) ((4 + (b) * 2 + (h)) * HTB)
#define PG8_STAGE(bufoff, gbase, voff) do { _Pragma("unroll") for (int _i = 0; _i < 2; ++_i) \
        __builtin_amdgcn_global_load_lds((const unsigned*)((const char*)(gbase) + (voff)[_i]), (PG8_LAS unsigned*)(lds + (bufoff) + ldsw + _i * 8192), 16, 0, 0); } while (0)
#define PG8_LDA(dst, b, h) do { _Pragma("unroll") for (int m = 0; m < 4; ++m) _Pragma("unroll") for (int k = 0; k < 2; ++k) dst[m][k] = *(const PG8_LAS bf16x8*)(lds + PG8_SA(b, h) + aoff + m * 2048 + k * 1024); } while (0)
#define PG8_LDB(dst, b, h) do { _Pragma("unroll") for (int n = 0; n < 2; ++n) _Pragma("unroll") for (int k = 0; k < 2; ++k) dst[n][k] = *(const PG8_LAS bf16x8*)(lds + PG8_SB(b, h) + boff + n * 2048 + k * 1024); } while (0)
#define PG8_MMA(ai, bj, At, Bt) do { __builtin_amdgcn_s_setprio(1); _Pragma("unroll") for (int m = 0; m < 4; ++m) _Pragma("unroll") for (int n = 0; n < 2; ++n) _Pragma("unroll") for (int k = 0; k < 2; ++k) \
        acc[ai][bj][m][n] = __builtin_amdgcn_mfma_f32_16x16x32_bf16(Bt[n][k], At[m][k], acc[ai][bj][m][n], 0, 0, 0); __builtin_amdgcn_s_setprio(0); } while (0)
#define PG8_WAIT_V(n) asm volatile("s_waitcnt vmcnt(" #n ")" ::: "memory")
#define PG8_WAIT_L(n) asm volatile("s_waitcnt lgkmcnt(" #n ")" ::: "memory")
#define PG8_BAR __builtin_amdgcn_s_barrier()
#define PG8_SCHED __builtin_amdgcn_sched_barrier(0)
    Unit cur, nxt; int ui = 0;
    if (!S.next(0, cur)) return;
    f32x4 acc[2][2][4][2];
#pragma unroll
    for (int a = 0; a < 2; ++a)
#pragma unroll
        for (int b = 0; b < 2; ++b)
#pragma unroll
            for (int m = 0; m < 4; ++m)
#pragma unroll
                for (int n = 0; n < 2; ++n) acc[a][b][m][n] = (f32x4){0.f, 0.f, 0.f, 0.f};
    bf16x8 At[4][2], B0[2][2], B1[2][2];
    const char* cA = (const char*)g.A + (size_t)cur.pm * tstep; const char* cB = (const char*)g.Bt + (size_t)cur.pn * tstep;
    S.a_ready(cur);
    if constexpr (SP2) {
        PG8_STAGE(PG8_SB(0, 0), cB, voffB); PG8_STAGE(PG8_SB(0, 1), cB + hstep, voffB); PG8_STAGE(PG8_SA(0, 0), cA, voffA); PG8_STAGE(PG8_SA(0, 1), cA + hstep, voffA);
        if (wr == 1) PG8_BAR;
        PG8_WAIT_V(2); PG8_BAR;
        PG8_STAGE(PG8_SB(1, 0), cB + kstep, voffB); PG8_STAGE(PG8_SA(1, 0), cA + kstep, voffA); PG8_STAGE(PG8_SB(1, 1), cB + hstep + kstep, voffB);
        PG8_WAIT_V(6); PG8_BAR;
    } else {
        PG8_STAGE(PG8_SB(0, 0), cB, voffB); PG8_STAGE(PG8_SA(0, 0), cA, voffA); PG8_STAGE(PG8_SB(0, 1), cB + hstep, voffB); PG8_STAGE(PG8_SA(0, 1), cA + hstep, voffA);
        if (wr == 1) PG8_BAR;
        PG8_WAIT_V(4); PG8_BAR;
        PG8_STAGE(PG8_SB(1, 0), cB + kstep, voffB); PG8_STAGE(PG8_SA(1, 0), cA + kstep, voffA); PG8_STAGE(PG8_SB(1, 1), cB + hstep + kstep, voffB);
        PG8_WAIT_V(6); PG8_BAR;
    }
    for (;;) {
        const bool has_next = S.next(ui + 1, nxt);
        const char* nA = has_next ? (const char*)g.A + (size_t)nxt.pm * tstep : cA; const char* nB = has_next ? (const char*)g.Bt + (size_t)nxt.pn * tstep : cB;
        for (int t = 0; t < nt; t += 2) {
            const bool last = (t == nt - 2);
            const char* a1 = cA + (size_t)(t + 1) * kstep;
            const char* a2 = last ? nA : cA + (size_t)(t + 2) * kstep; const char* b2 = last ? nB : cB + (size_t)(t + 2) * kstep;
            const char* a3 = a2 + kstep; const char* b3 = b2 + kstep;
            if (last && has_next) S.a_ready(nxt);
            if constexpr (SP2) {
            PG8_LDB(B0, 0, 0); PG8_LDB(B1, 0, 1); PG8_SCHED; PG8_LDA(At, 0, 0); PG8_STAGE(PG8_SA(1, 1), a1 + hstep, voffA);
            PG8_WAIT_V(8); PG8_WAIT_L(0); PG8_BAR; PG8_MMA(0, 0, At, B0); PG8_MMA(0, 1, At, B1); PG8_BAR; PG8_SCHED;
            PG8_LDA(At, 0, 1); PG8_STAGE(PG8_SB(0, 0), b2, voffB); PG8_STAGE(PG8_SB(0, 1), b2 + hstep, voffB); PG8_STAGE(PG8_SA(0, 0), a2, voffA);
            PG8_WAIT_V(8); PG8_WAIT_L(0); PG8_BAR; PG8_MMA(1, 0, At, B0); PG8_MMA(1, 1, At, B1); PG8_BAR; PG8_SCHED;
            PG8_LDB(B0, 1, 0); PG8_LDB(B1, 1, 1); PG8_SCHED; PG8_LDA(At, 1, 0); PG8_STAGE(PG8_SA(0, 1), a2 + hstep, voffA);
            PG8_WAIT_V(8); PG8_WAIT_L(0); PG8_BAR; PG8_MMA(0, 0, At, B0); PG8_MMA(0, 1, At, B1); PG8_BAR; PG8_SCHED;
            PG8_LDA(At, 1, 1); PG8_STAGE(PG8_SB(1, 0), b3, voffB); PG8_STAGE(PG8_SB(1, 1), b3 + hstep, voffB); PG8_STAGE(PG8_SA(1, 0), a3, voffA);
            PG8_WAIT_V(8); PG8_WAIT_L(0); PG8_BAR; PG8_MMA(1, 0, At, B0); PG8_MMA(1, 1, At, B1); PG8_BAR; PG8_SCHED;
            } else {
            PG8_LDB(B0, 0, 0); PG8_SCHED; PG8_LDA(At, 0, 0); PG8_STAGE(PG8_SA(1, 1), a1 + hstep, voffA);
            PG8_WAIT_L(8); PG8_BAR; PG8_WAIT_L(0); PG8_MMA(0, 0, At, B0); PG8_BAR; PG8_SCHED;
            PG8_LDB(B1, 0, 1); PG8_STAGE(PG8_SB(0, 0), b2, voffB);
            PG8_BAR; PG8_WAIT_L(0); PG8_MMA(0, 1, At, B1); PG8_BAR;
            PG8_LDA(At, 0, 1); PG8_STAGE(PG8_SA(0, 0), a2, voffA);
            PG8_BAR; PG8_WAIT_L(0); PG8_MMA(1, 0, At, B0); PG8_BAR; PG8_SCHED;
            PG8_STAGE(PG8_SB(0, 1), b2 + hstep, voffB);
            PG8_WAIT_V(6); PG8_BAR; PG8_MMA(1, 1, At, B1); PG8_BAR;
            PG8_LDB(B0, 1, 0); PG8_SCHED; PG8_LDA(At, 1, 0); PG8_STAGE(PG8_SA(0, 1), a2 + hstep, voffA);
            PG8_WAIT_L(8); PG8_BAR; PG8_WAIT_L(0); PG8_MMA(0, 0, At, B0); PG8_BAR; PG8_SCHED;
            PG8_LDB(B1, 1, 1); PG8_STAGE(PG8_SB(1, 0), b3, voffB);
            PG8_BAR; PG8_WAIT_L(0); PG8_MMA(0, 1, At, B1); PG8_BAR;
            PG8_LDA(At, 1, 1); PG8_STAGE(PG8_SA(1, 0), a3, voffA);
            PG8_BAR; PG8_WAIT_L(0); PG8_MMA(1, 0, At, B0); PG8_BAR; PG8_SCHED;
            PG8_STAGE(PG8_SB(1, 1), b3 + hstep, voffB);
            PG8_WAIT_V(6); PG8_BAR; PG8_MMA(1, 1, At, B1); PG8_BAR;
            }
        }
        if constexpr (ALIGN_EPI) { if (wr == 0) PG8_BAR; }
        if constexpr (!Epi::AFTER_DRAIN) { E(acc, cur, wr, wc, fr, fq); S.done(cur); }
        if (!has_next) break;
#pragma unroll
        for (int a = 0; a < 2; ++a)
#pragma unroll
            for (int b = 0; b < 2; ++b)
#pragma unroll
                for (int m = 0; m < 4; ++m)
#pragma unroll
                    for (int n = 0; n < 2; ++n) acc[a][b][m][n] = (f32x4){0.f, 0.f, 0.f, 0.f};
        cur = nxt; cA = nA; cB = nB; ++ui;
        if constexpr (ALIGN_EPI) { if (wr == 1) PG8_BAR; }
    }
    PG8_WAIT_V(0);
    if constexpr (!ALIGN_EPI) { if (wr == 0) PG8_BAR; }
    PG8_BAR;
    if constexpr (Epi::AFTER_DRAIN) { E.fused(acc, cur, wr, wc, fr, fq, lds, wid, lane); S.done(cur); }
#undef PG8_SA
#undef PG8_SB
#undef PG8_STAGE
#undef PG8_LDA
#undef PG8_LDB
#undef PG8_MMA
#undef PG8_WAIT_V
#undef PG8_WAIT_L
#undef PG8_BAR
#undef PG8_SCHED
}
}

template <int NBLK, int RB, int NPASS, class RowMap, class Epi>
__device__ __forceinline__ void skinny_gemm(const bf16* __restrict__ A, int lda, const bf16* __restrict__ Bt, int K, const RowMap& rm, const Epi& epi, LAS float* part, int rot_seed, int row0) {
    constexpr int ROWS = RB * 16, NC = NBLK * 16, UNR = (RB + NBLK) <= 5 ? 4 : (NBLK <= 2 ? 4 : 2);
    int tid = threadIdx.x; asm volatile("" : "+v"(tid));
    const int w = __builtin_amdgcn_readfirstlane(tid >> 6), lane = tid & 63, r16 = lane & 15, kq = lane >> 4;
    const int Kw = K >> 3, ksteps = Kw >> 5, kbase = w * Kw + 8 * kq, rot = rot_seed % ksteps;
    const bf16* bp[NBLK];
#pragma unroll
    for (int bk = 0; bk < NBLK; ++bk) { const int br = rm(bk, r16); bp[bk] = br >= 0 ? Bt + (size_t)br * K + kbase : nullptr; }
#pragma unroll 1
    for (int pass = 0; pass < NPASS; ++pass) {
        f32x4 acc[RB][NBLK];
#pragma unroll
        for (int rb = 0; rb < RB; ++rb)
#pragma unroll
            for (int bk = 0; bk < NBLK; ++bk) acc[rb][bk] = (f32x4){0.f, 0.f, 0.f, 0.f};
        const bf16* ap = A + (size_t)(row0 + pass * ROWS + r16) * lda + kbase;
#pragma unroll 1
        for (int ks0 = 0; ks0 < ksteps; ks0 += UNR) {
            bf16x8 a[UNR][RB], b[UNR][NBLK];
#pragma unroll
            for (int u = 0; u < UNR; ++u) { int ks = (ks0 + u < ksteps ? ks0 + u : ksteps - 1) + rot; ks = ks >= ksteps ? ks - ksteps : ks;
#pragma unroll
                for (int rb = 0; rb < RB; ++rb) a[u][rb] = *(const GAS bf16x8*)(ap + (size_t)(rb * 16) * lda + 32 * ks);
#pragma unroll
                for (int bk = 0; bk < NBLK; ++bk) { b[u][bk] = (bf16x8){0, 0, 0, 0, 0, 0, 0, 0}; if (bp[bk] && ks0 + u < ksteps) b[u][bk] = *(const GAS bf16x8*)(bp[bk] + 32 * ks); } }
#pragma unroll
            for (int u = 0; u < UNR; ++u)
#pragma unroll
                for (int rb = 0; rb < RB; ++rb)
#pragma unroll
                    for (int bk = 0; bk < NBLK; ++bk) acc[rb][bk] = __builtin_amdgcn_mfma_f32_16x16x32_bf16(a[u][rb], b[u][bk], acc[rb][bk], 0, 0, 0);
        }
        constexpr int NH = (8 * ROWS * NC * 4 > 131072) ? 2 : 1, RBH = RB / NH, ROWSH = RBH * 16;
#pragma unroll
        for (int hf = 0; hf < NH; ++hf) {
            LAS float* pw = part + w * (ROWSH * NC);
#pragma unroll
            for (int rb = 0; rb < RBH; ++rb)
#pragma unroll
                for (int bk = 0; bk < NBLK; ++bk)
#pragma unroll
                    for (int i = 0; i < 4; ++i) pw[(rb * 16 + 4 * kq + i) * NC + bk * 16 + r16] = acc[hf * RBH + rb][bk][i];
            __syncthreads();
            int tid2 = tid; asm volatile("" : "+v"(tid2));
#pragma unroll
            for (int t = 0; t < (ROWSH * 16 + 511) / 512; ++t) { const int pr = tid2 + 512 * t, row = pr >> 4, j = pr & 15; float vals[NBLK]; if (ROWSH * 16 < 512 && pr >= ROWSH * 16) break;
#pragma unroll
                for (int bk = 0; bk < NBLK; ++bk) { float s = 0.f;
#pragma unroll
                    for (int ww = 0; ww < 8; ++ww) s += part[ww * (ROWSH * NC) + row * NC + bk * 16 + j];
                    vals[bk] = s; }
                epi(row0 + pass * ROWS + hf * ROWSH + row, j, vals); }
            __syncthreads();
        }
    }
}
__device__ __forceinline__ float sk_fix(float v, const float* cb, int nrow, float mu, float rstd) { const f32x2 c = *(const GAS f32x2*)(cb + 2 * nrow); return rstd * (v - mu * c[0]) + c[1]; }
struct SkMapLinear { int n0, cnt; __device__ __forceinline__ int operator()(int, int j) const { return j < cnt ? n0 + j : -1; } };
struct SkMapLinear2 { int n0; __device__ __forceinline__ int operator()(int bk, int j) const { return n0 + bk * 16 + j; } };
struct SkEpiResid {
    bf16* X; int n0; float cs, al; const float* sto; const float* g; const float* b; float* stn; int ln;
    __device__ __forceinline__ void operator()(int row, int j, const float (&v)[2]) const { const int r = MP + row; bf16* p = X + (size_t)r * DM + n0 + j;
        float x0 = bf2f(p[0]), x1 = bf2f(p[16]);
        if (ln) { float mu, rstd; pg8::row_mu_rstd(sto, r, mu, rstd); x0 = (x0 - mu) * rstd * g[n0 + j] + b[n0 + j]; x1 = (x1 - mu) * rstd * g[n0 + 16 + j] + b[n0 + 16 + j]; }
        const float y0 = x0 * al + cs * v[0], y1 = x1 * al + cs * v[1]; p[0] = (bf16)f2bf(y0); p[16] = (bf16)f2bf(y1);
        float s1 = y0 + y1, s2 = y0 * y0 + y1 * y1;
#pragma unroll
        for (int o = 1; o < 16; o <<= 1) { s1 += __shfl_xor(s1, o); s2 += __shfl_xor(s2, o); }
        if (j == 0) { atomicAdd(stn + 2 * (size_t)r, s1); atomicAdd(stn + 2 * (size_t)r + 1, s2); } }
};
struct SkMapSwiglu { int h0;
    __device__ __forceinline__ int operator()(int bk, int j) const { const int i = (bk >> 1) * 16 + j; if (i >= 22) return -1; const int hh = h0 + i; return (hh >> 7) * 256 + (hh & 127) + (bk & 1) * 128; } };
struct SkEpiSwiglu { bf16* H; int h0; const float* st; const float* cb; int ln;
    __device__ __forceinline__ void operator()(int row, int j, const float (&v)[4]) const {
        bf16* p = H + (size_t)(MP + row) * DFF + h0; float mu = 0.f, rstd = 1.f; if (ln) pg8::row_mu_rstd(st, MP + row, mu, rstd);
        { const int hh = h0 + j, nr = (hh >> 7) * 256 + (hh & 127); float g = v[0], u = v[1]; if (ln) { g = sk_fix(g, cb, nr, mu, rstd); u = sk_fix(u, cb, nr + 128, mu, rstd); }
          const float e = __builtin_amdgcn_exp2f(g * -1.4426950408889634f); p[j] = (bf16)f2bf(g * __builtin_amdgcn_rcpf(1.0f + e) * u); }
        if (j < 6) { const int hh = h0 + 16 + j, nr = (hh >> 7) * 256 + (hh & 127); float g = v[2], u = v[3]; if (ln) { g = sk_fix(g, cb, nr, mu, rstd); u = sk_fix(u, cb, nr + 128, mu, rstd); }
          const float e = __builtin_amdgcn_exp2f(g * -1.4426950408889634f); p[16 + j] = (bf16)f2bf(g * __builtin_amdgcn_rcpf(1.0f + e) * u); } }
};
struct SkEpiInB { unsigned char* ws; float* out; int n0; const float* st; const float* cb;
    __device__ __forceinline__ void operator()(int row, int j, const float (&v)[1]) const { if (j >= 12) return; const int n = n0 + j; const size_t r = (size_t)MP + row; float mu, rstd; pg8::row_mu_rstd(st, MP + row, mu, rstd); const float x = sk_fix(v[0], cb, n, mu, rstd);
        if (n < NQ) ((bf16*)(ws + WS_R1 + R1_Q))[r * NQ + n] = (bf16)f2bf(x);
        else if (n < NQ + 2 * NKV) { const int isv = n >= NQ + NKV, c = n - NQ - isv * NKV; ((bf16*)(ws + WS_R1 + (isv ? R1_V : R1_K)))[r * NKV + c] = (bf16)f2bf(x);
            out[(isv ? O_BVS : O_BKS) + ((size_t)(row >> 4) * 512 + (BBUF - DS) + (row & 15)) * 512 + c] = x; }
        else ((bf16*)(ws + WS_R1 + R1_QM))[r * NMQ + (n - NQ - 2 * NKV)] = (bf16)f2bf(x); }
};
__device__ __forceinline__ int ska_pair_row(int p, int x2) {
    int tile, lc;
    if (p < 768) { const int h = p >> 6, d = p & 63; tile = h >> 1; lc = (h & 1) * 64 + d; }
    else if (p < 1024) { const int pp = p - 768, h = pp >> 6, d = pp & 63; tile = 6 + (h >> 1); lc = (h & 1) * 64 + d; }
    else if (p < 1280) { const int pp = p - 1024, h = pp >> 5, d = pp & 31; tile = 12 + (h >> 2); lc = (h & 3) * 32 + d; }
    else { tile = 14; lc = p - 1280; }
    return tile * 256 + lc + x2 * 128; }
struct SkMapInA { int wg;
    __device__ __forceinline__ int operator()(int bk, int j) const {
        if (j < 6) { const int p = 6 * wg + j; return p < 1312 ? ska_pair_row(p, bk) : -1; }
        if (bk == 1 || j >= 11) return -1;
        const int s = 5 * wg + (j - 6); if (s >= 1032) return -1;
        return s < 1024 ? 2048 + s : 14 * 256 + 32 + (s - 1024); } };
struct SkEpiInA { unsigned char* ws; float* out; int wg; const float* st; const float* cb;
    __device__ __forceinline__ void operator()(int row, int j, const float (&vin)[2]) const {
        const size_t r = (size_t)MP + row; const int pos = PAST + (row & 15); float mu, rstd; pg8::row_mu_rstd(st, MP + row, mu, rstd); float v[2] = {vin[0], vin[1]};
        if (j < 6) { const int p = 6 * wg + j; if (p < 1312) { v[0] = sk_fix(v[0], cb, ska_pair_row(p, 0), mu, rstd); v[1] = sk_fix(v[1], cb, ska_pair_row(p, 1), mu, rstd); } }
        else if (j < 11) { const int s = 5 * wg + (j - 6); if (s < 1032) v[0] = sk_fix(v[0], cb, s < 1024 ? 2048 + s : 14 * 256 + 32 + (s - 1024), mu, rstd); }
        if (j < 6) { const int p = 6 * wg + j; if (p >= 1312) return;
            if (p < 1024) { const int isk = p >= 768, pp = isk ? p - 768 : p, h = pp >> 6, d = pp & 63;
                const float c = ((const float*)(ws + WS_COS128))[pos * 64 + d], s = ((const float*)(ws + WS_SIN128))[pos * 64 + d];
                const float o1 = v[0] * c - v[1] * s, o2 = v[1] * c + v[0] * s;
                if (!isk) { bf16* q = (bf16*)(ws + WS_R1 + R1_Q) + r * NQ + h * 128 + d; q[0] = (bf16)f2bf(o1); q[64] = (bf16)f2bf(o2); }
                else { bf16* k = (bf16*)(ws + WS_R1 + R1_K) + r * NKV + h * 128 + d; k[0] = (bf16)f2bf(o1); k[64] = (bf16)f2bf(o2); float* o = out + O_AKS + (size_t)row * 512 + h * 128 + d; o[0] = o1; o[64] = o2; } }
            else { const int isk = p >= 1280, pp = isk ? p - 1280 : p - 1024, h = isk ? 0 : pp >> 5, d = pp & 31;
                const float c = ((const float*)(ws + WS_COS64))[pos * 32 + d], s = ((const float*)(ws + WS_SIN64))[pos * 32 + d];
                const float o1 = v[0] * c - v[1] * s, o2 = v[1] * c + v[0] * s;
                if (!isk) { bf16* q = (bf16*)(ws + WS_R1 + R1_QI) + r * NIQ + h * 64 + d; q[0] = (bf16)f2bf(o1); q[32] = (bf16)f2bf(o2); }
                else { bf16* k = (bf16*)(ws + WS_R1 + R1_KI); k[ki_tiled(r, d)] = (bf16)f2bf(o1); k[ki_tiled(r, d + 32)] = (bf16)f2bf(o2); float* o = out + O_AIS + (size_t)row * 64 + d; o[0] = o1; o[32] = o2; } }
        } else if (j < 11) { const int s = 5 * wg + (j - 6); if (s >= 1032) return; const float x = v[0];
            if (s < 512) { ((bf16*)(ws + WS_R1 + R1_V))[r * NKV + s] = (bf16)f2bf(x); out[O_AVS + (size_t)row * 512 + s] = x; }
            else if (s < 1024) ((bf16*)(ws + WS_R1 + R1_QM))[r * NMQ + (s - 512)] = (bf16)f2bf(x);
            else ((float*)(ws + WS_R1 + R1_WI))[r * NIH + (s - 1024)] = x; }
    }
};

struct Params { const float* in[21]; float* out; unsigned char* ws; int ph_lo, ph_hi; };
struct Frame {
    LAS unsigned char* lds;
    int tid, lane, wave, G, bx;
    const Params* P; float* out; unsigned char* ws;
};
enum { IN_XP = 0, IN_XS, IN_MEMP, IN_CAK, IN_CAV, IN_CAI, IN_CBK, IN_CBV, IN_CMK, IN_CMV, IN_WINA, IN_WINB, IN_WO, IN_RELB, IN_WMEM, IN_F1I, IN_F1O, IN_F2I, IN_F2O, IN_LNG, IN_LNB };

enum { TM_ID = 0, TM_FFN_IN = 1, TM_INA = 2 };
__device__ __forceinline__ int srcmap(int mode, int n) {
    if (mode == TM_ID) return n;
    const int tile = n >> 8, w = n & 255, half = w >> 7, lc = w & 127;
    if (mode == TM_FFN_IN) return half ? DFF + tile * 128 + lc : tile * 128 + lc;
    if (tile < 6) return (2 * tile + (lc >> 6)) * 128 + (lc & 63) + 64 * half;
    if (tile < 8) return NQ + (2 * (tile - 6) + (lc >> 6)) * 128 + (lc & 63) + 64 * half;
    if (tile < 12) return n;
    if (tile < 14) return 3072 + (4 * (tile - 12) + (lc >> 5)) * 64 + (lc & 31) + 32 * half;
    if (lc < 32) return 3584 + lc + 32 * half;
    if (half == 0 && lc < 40) return 3648 + (lc - 32);
    return -1;
}
struct TpItem { const float* W; int K, N; bf16* WT; int mode, item, nblk; const float* gk; const float* bk; float* cbo; };
__device__ __forceinline__ void tp_load(const TpItem& d, int lane, f32x4 (&v)[16]) {
    const int kb = d.item / d.nblk, nb = d.item % d.nblk, k0 = 64 * kb, n0 = 64 * nb, n4 = (lane & 15) * 4, src = srcmap(d.mode, n0 + n4);
#pragma unroll
    for (int i = 0; i < 16; ++i) { const int kk = 4 * i + (lane >> 4); v[i] = (f32x4){0.f, 0.f, 0.f, 0.f};
        if (src >= 0) v[i] = *(const GAS f32x4*)(d.W + (size_t)(k0 + kk) * d.N + src); }
}
__device__ __forceinline__ void tp_to_lds(const TpItem& d, int lane, f32x4 (&v)[16], LAS float* scr) {
    const int kb = d.item / d.nblk, nb = d.item % d.nblk, k0 = 64 * kb, n0 = 64 * nb, n4 = (lane & 15) * 4;
    f32x4 csp = {0.f, 0.f, 0.f, 0.f}, bwp = {0.f, 0.f, 0.f, 0.f};
#pragma unroll
    for (int i = 0; i < 16; ++i) { const int kk = 4 * i + (lane >> 4); f32x4 x = v[i];
        if (d.gk) { const float gg = d.gk[k0 + kk], bb = d.bk[k0 + kk]; bwp += x * bb; x = x * gg;
            csp[0] += bf2f((bf16)f2bf(x[0])); csp[1] += bf2f((bf16)f2bf(x[1])); csp[2] += bf2f((bf16)f2bf(x[2])); csp[3] += bf2f((bf16)f2bf(x[3])); }
        LAS float* q = scr + kk * 65 + n4; q[0] = x[0]; q[1] = x[1]; q[2] = x[2]; q[3] = x[3]; }
    if (d.gk) {
#pragma unroll
        for (int e = 0; e < 4; ++e) { csp[e] += __shfl_xor(csp[e], 16); csp[e] += __shfl_xor(csp[e], 32); bwp[e] += __shfl_xor(bwp[e], 16); bwp[e] += __shfl_xor(bwp[e], 32); }
        if (lane < 16) {
#pragma unroll
            for (int e = 0; e < 4; ++e) { atomicAdd(d.cbo + 2 * (n0 + n4 + e), csp[e]); atomicAdd(d.cbo + 2 * (n0 + n4 + e) + 1, bwp[e]); } } }
}
__device__ __forceinline__ void tp_from_lds(const TpItem& d, int lane, LAS float* scr) {
    const int kb = d.item / d.nblk, nb = d.item % d.nblk, k0 = 64 * kb, n0 = 64 * nb, c = lane & 7;
    LDS_WAIT(); asm volatile("" ::: "memory");
#pragma unroll
    for (int j = 0; j < 8; ++j) { const int n = (lane >> 3) + 8 * j; const LAS float* sp = scr + (8 * c) * 65 + n;
        u32x4 o; o.x = pk2(sp[0 * 65], sp[1 * 65]); o.y = pk2(sp[2 * 65], sp[3 * 65]); o.z = pk2(sp[4 * 65], sp[5 * 65]); o.w = pk2(sp[6 * 65], sp[7 * 65]);
        *(GAS u32x4*)(d.WT + (size_t)(n0 + n) * d.K + k0 + 8 * c) = o; }
    LDS_WAIT(); asm volatile("" ::: "memory");
}
__device__ __forceinline__ TpItem tp_decode(Frame& F, int it) {
    unsigned char* ws = F.ws;
    constexpr int I_FI = (DM / 64) * (NFF2 / 64), I_FO = (DFF / 64) * (DM / 64), I_INA = (DM / 64) * (PROJ_A_PAD / 64), I_INB = (DM / 64) * (PROJ_B / 64), I_O = (DM / 64) * (DM / 64), I_MEM = (DM / 64) * (1024 / 64);
    int r = it; TpItem d;
    if (r < 4 * I_FI) { const int w = r / I_FI, l = w >> 1, f = w & 1; r -= w * I_FI;
        const int gi = w == 1 ? 1 : w == 2 ? 2 : 4;
        d = TpItem{(f ? F.P->in[IN_F2I] : F.P->in[IN_F1I]) + (size_t)l * DM * NFF2, DM, NFF2, (bf16*)(ws + WS_WFI + (size_t)w * 44 * MiB), TM_FFN_IN, r, NFF2 / 64,
                   w ? F.P->in[IN_LNG] + (size_t)gi * DM : nullptr, w ? F.P->in[IN_LNB] + (size_t)gi * DM : nullptr, (float*)(ws + CTL_CSBW) + (size_t)(w ? w - 1 : 0) * CSBW_STRIDE}; return d; } r -= 4 * I_FI;
    if (r < 4 * I_FO) { const int w = r / I_FO, l = w >> 1, f = w & 1; r -= w * I_FO;
        d = TpItem{(f ? F.P->in[IN_F2O] : F.P->in[IN_F1O]) + (size_t)l * DFF * DM, DFF, DM, (bf16*)(ws + WS_WFO + (size_t)w * 22 * MiB), TM_ID, r, DM / 64, nullptr, nullptr, nullptr}; return d; } r -= 4 * I_FO;
    if (r < I_INA) { d = TpItem{F.P->in[IN_WINA], DM, PROJ_A, (bf16*)(ws + WS_WINA), TM_INA, r, PROJ_A_PAD / 64, F.P->in[IN_LNG], F.P->in[IN_LNB], (float*)(ws + CTL_CSBW) + (size_t)FM_INA * CSBW_STRIDE}; return d; } r -= I_INA;
    if (r < I_INB) { d = TpItem{F.P->in[IN_WINB], DM, PROJ_B, (bf16*)(ws + WS_WINB), TM_ID, r, PROJ_B / 64, F.P->in[IN_LNG] + 3 * DM, F.P->in[IN_LNB] + 3 * DM, (float*)(ws + CTL_CSBW) + (size_t)FM_INB * CSBW_STRIDE}; return d; } r -= I_INB;
    if (r < 2 * I_O) { const int l = r / I_O; r -= l * I_O; d = TpItem{F.P->in[IN_WO] + (size_t)l * DM * DM, DM, DM, (bf16*)(ws + WS_WO + (size_t)l * 8 * MiB), TM_ID, r, DM / 64, nullptr, nullptr, nullptr}; return d; } r -= 2 * I_O;
    { const int l = r / I_MEM; r -= l * I_MEM; d = TpItem{F.P->in[IN_WMEM] + (size_t)l * DM * 1024, DM, 1024, (bf16*)(ws + WS_WMEM) + (size_t)l * 1024 * DM, TM_ID, r, 1024 / 64, nullptr, nullptr, nullptr}; return d; }
}
__device__ __forceinline__ void p0_prologue(Frame& F) {
    LAS float* scr = (LAS float*)(F.lds + F.wave * 16640);
    const int gw = F.bx * NWAVES + F.wave, NGW = F.G * NWAVES;
    unsigned char* ws = F.ws;
    constexpr int NITEMS = 4 * ((DM / 64) * (NFF2 / 64)) + 4 * ((DFF / 64) * (DM / 64)) + (DM / 64) * (PROJ_A_PAD / 64) + (DM / 64) * (PROJ_B / 64) + 2 * ((DM / 64) * (DM / 64)) + 2 * ((DM / 64) * (1024 / 64));
    if (gw < NITEMS) {
        TpItem cur = tp_decode(F, gw); f32x4 v[16]; tp_load(cur, F.lane, v);
        for (int it = gw; it < NITEMS; it += NGW) {
            tp_to_lds(cur, F.lane, v, scr);
            const bool has = it + NGW < NITEMS; TpItem nx = cur;
            if (has) { nx = tp_decode(F, it + NGW); tp_load(nx, F.lane, v); }
            tp_from_lds(cur, F.lane, scr);
            cur = nx;
        }
    }
    { const int gt = F.bx * (NWAVES * 64) + F.tid, NGT = F.G * NWAVES * 64; f32x4* z = (f32x4*)(ws + WS_STATS); for (int i = gt; i < (int)(6 * (size_t)MPAD * 2 / 4); i += NGT) z[i] = (f32x4){0.f, 0.f, 0.f, 0.f}; }
    for (int m = gw; m < MPAD + NB * NMEM; m += NGW) {
        const float* src; bf16* dst;
        if (m < MP) { src = F.P->in[IN_XP] + (size_t)m * DM; dst = (bf16*)(ws + WS_X) + (size_t)m * DM; }
        else if (m < MR) { src = F.P->in[IN_XS] + (size_t)(m - MP) * DM; dst = (bf16*)(ws + WS_X) + (size_t)m * DM; }
        else if (m < MPAD) { src = nullptr; dst = (bf16*)(ws + WS_X) + (size_t)m * DM; }
        else { src = F.P->in[IN_MEMP] + (size_t)(m - MPAD) * DM; dst = (bf16*)(ws + WS_MEMB) + (size_t)(m - MPAD) * DM; }
#pragma unroll
        for (int j = 0; j < 4; ++j) { const int e = 512 * j + 8 * F.lane; u32x4 o = {0u, 0u, 0u, 0u};
            if (src) { const f32x4 a = *(const GAS f32x4*)(src + e), b = *(const GAS f32x4*)(src + e + 4); o.x = pk2(a[0], a[1]); o.y = pk2(a[2], a[3]); o.z = pk2(b[0], b[1]); o.w = pk2(b[2], b[3]); }
            *(GAS u32x4*)(dst + e) = o; }
    }
    { float* c128 = (float*)(ws + WS_COS128); float* s128 = (float*)(ws + WS_SIN128); float* c64 = (float*)(ws + WS_COS64); float* s64 = (float*)(ws + WS_SIN64);
      const int gt = F.bx * (NWAVES * 64) + F.tid, NGT = F.G * NWAVES * 64;
      for (int i = gt; i < SEQ * 96; i += NGT) { const int pos = i / 96, j = i % 96;
          const int half = j < 64 ? 64 : 32, fi = j < 64 ? j : j - 64;
          const float ex = -(float)fi / (float)half; const float invf = (float)pow(10000.0, (double)ex); const float ang = (float)pos * invf;
          const float cv = (float)cos((double)ang), sv = (float)sin((double)ang);
          if (j < 64) { c128[pos * 64 + fi] = cv; s128[pos * 64 + fi] = sv; } else { c64[pos * 32 + fi] = cv; s64[pos * 32 + fi] = sv; } } }
    { const int gt = F.bx * (NWAVES * 64) + F.tid, NGT = F.G * NWAVES * 64; constexpr int PER = (BBUF - DS) * 512 / 4;
      for (int i = gt; i < 2 * DB * PER; i += NGT) { const int kv = i / (DB * PER), r = i % (DB * PER), b = r / PER, e = r % PER;
          const f32x4 vv = *(const GAS f32x4*)((kv ? F.P->in[IN_CBV] : F.P->in[IN_CBK]) + ((size_t)b * BBUF + DS) * 512 + (size_t)e * 4);
          *(GAS f32x4*)(F.out + (kv ? O_BVS : O_BKS) + (size_t)b * BBUF * 512 + (size_t)e * 4) = vv; } }
}

__device__ __forceinline__ void ln_phase(Frame& F, const float* g, const float* b, float* yout, float ys_scale = 1.0f) {
    const int gw = F.bx * NWAVES + F.wave, NGW = F.G * NWAVES;
    bf16* X = (bf16*)(F.ws + WS_X);
    f32x4 gg[4][2], bb[4][2];
#pragma unroll
    for (int j = 0; j < 4; ++j) { const int e = 512 * j + 8 * F.lane; gg[j][0] = *(const GAS f32x4*)(g + e); gg[j][1] = *(const GAS f32x4*)(g + e + 4); bb[j][0] = *(const GAS f32x4*)(b + e); bb[j][1] = *(const GAS f32x4*)(b + e + 4); }
    const int nrows = MR;
    for (int m0 = 2 * gw; m0 < nrows; m0 += 2 * NGW) {
        f32x4 v[2][4][2]; float s[2] = {0.f, 0.f};
#pragma unroll
        for (int r = 0; r < 2; ++r) { const int m = (m0 + r < nrows) ? m0 + r : m0; const bf16* xr = X + (size_t)m * DM;
#pragma unroll
            for (int j = 0; j < 4; ++j) { const u32x4 w = *(const GAS u32x4*)(xr + 512 * j + 8 * F.lane);
                v[r][j][0][0] = __builtin_bit_cast(float, w.x << 16); v[r][j][0][1] = __builtin_bit_cast(float, w.x & 0xffff0000u); v[r][j][0][2] = __builtin_bit_cast(float, w.y << 16); v[r][j][0][3] = __builtin_bit_cast(float, w.y & 0xffff0000u);
                v[r][j][1][0] = __builtin_bit_cast(float, w.z << 16); v[r][j][1][1] = __builtin_bit_cast(float, w.z & 0xffff0000u); v[r][j][1][2] = __builtin_bit_cast(float, w.w << 16); v[r][j][1][3] = __builtin_bit_cast(float, w.w & 0xffff0000u); } }
#pragma unroll
        for (int r = 0; r < 2; ++r)
#pragma unroll
            for (int j = 0; j < 4; ++j)
#pragma unroll
                for (int h = 0; h < 2; ++h) s[r] += (v[r][j][h][0] + v[r][j][h][1]) + (v[r][j][h][2] + v[r][j][h][3]);
#pragma unroll
        for (int r = 0; r < 2; ++r) { const int m = m0 + r; if (m >= nrows) break;
            bf16* xr = X + (size_t)m * DM;
            const float mean = wave_sum(s[r]) * (1.f / DM); float s2 = 0.f;
#pragma unroll
            for (int j = 0; j < 4; ++j)
#pragma unroll
                for (int h = 0; h < 2; ++h) { v[r][j][h] = v[r][j][h] - mean; s2 += (v[r][j][h][0] * v[r][j][h][0] + v[r][j][h][1] * v[r][j][h][1]) + (v[r][j][h][2] * v[r][j][h][2] + v[r][j][h][3] * v[r][j][h][3]); }
            const float rstd = 1.f / sqrtf(wave_sum(s2) * (1.f / DM) + LN_EPS);
#pragma unroll
            for (int j = 0; j < 4; ++j) { const f32x4 o0 = v[r][j][0] * rstd * gg[j][0] + bb[j][0], o1 = v[r][j][1] * rstd * gg[j][1] + bb[j][1];
                if (yout) { float* yo = yout + (m < MP ? O_YP + (size_t)m * DM : O_YS + (size_t)(m - MP) * DM) + 512 * j + 8 * F.lane; const float sc_ = m < MP ? 1.0f : ys_scale; *(GAS f32x4*)yo = o0 * sc_; *(GAS f32x4*)(yo + 4) = o1 * sc_; }
                else { u32x4 o; o.x = cvt_pk_bf16(o0[0], o0[1]); o.y = cvt_pk_bf16(o0[2], o0[3]); o.z = cvt_pk_bf16(o1[0], o1[1]); o.w = cvt_pk_bf16(o1[2], o1[3]); *(GAS u32x4*)(xr + 512 * j + 8 * F.lane) = o; } } }
    }
}

template <class Sched>
__device__ __forceinline__ void stats_finalize_local(Frame& F, const Sched& S, const float* part, float* st) {
    int pa = -1, pb = -1; pg8::Unit u;
    for (int i = 0;; ++i) { const bool more = S.next(i, u); bool flush = !more;
        if (more && u.pm != pa && u.pm != pb) { if (pa < 0) pa = u.pm; else if (pb < 0) pb = u.pm; else { flush = true; --i; } }
        if (flush) { const int pm = (F.tid >> 8) ? pb : pa;
            if (pm >= 0) { const size_t row = (size_t)pm * 256 + (F.tid & 255); const float* pr = part + row * 64; f32x4 v[16];
#pragma unroll
                for (int k = 0; k < 16; ++k) v[k] = *(const GAS f32x4*)(pr + 4 * k);
                float s1 = 0.f, s2 = 0.f;
#pragma unroll
                for (int k = 0; k < 16; ++k) { s1 += v[k][0] + v[k][2]; s2 += v[k][1] + v[k][3]; }
                *(GAS f32x2*)(st + 2 * row) = (f32x2){s1, s2}; }
            pa = pb = -1; }
        if (!more) break; }
    __syncthreads();
}

__device__ __forceinline__ void stats_finalize(Frame& F, const float* part, float* st) {
    const int gw = F.bx * NWAVES + F.wave, NGW = F.G * NWAVES, half = F.lane >> 5, sl = F.lane & 31;
    for (int r0 = 2 * gw; r0 < MP; r0 += 2 * NGW) { const int row = r0 + half;
        f32x2 v = *(const GAS f32x2*)(part + ((size_t)row * 32 + sl) * 2);
#pragma unroll
        for (int o = 1; o < 32; o <<= 1) { v[0] += __shfl_xor(v[0], o); v[1] += __shfl_xor(v[1], o); }
        if (sl == 0) *(GAS f32x2*)(st + 2 * (size_t)row) = v; }
}


namespace att {
constexpr int D = 128, NW = 8, QBLK = 32, KVBLK = 64, LDK = 512, LDO = DM;
constexpr float SCALE = ATT_SCALE, THR = 8.f;
constexpr int SHM_V = KVBLK * D * 2, SHM_K = KVBLK * D * 2, SHM_WS = 2 * SHM_V + 2 * SHM_K, SHM_TBL = SHM_WS + NW * 64 * 4, SHM_ATTN = SHM_TBL + 260 * 4;
#define KSWZ(row, colB) ((row) * 256 + ((colB) ^ (((row) & 7) << 4)))
#define SBAR() __builtin_amdgcn_sched_barrier(0)
__device__ __forceinline__ int crow(int r, int hi) { return (r & 3) + 8 * (r >> 2) + 4 * hi; }
__device__ __forceinline__ unsigned cvtpk(float lo, float hi) { unsigned r; asm volatile("v_cvt_pk_bf16_f32 %0, %1, %2" : "=v"(r) : "v"(lo), "v"(hi)); return r; }

__device__ __forceinline__ void partialSM(f32x16& p0, f32x16& p1, float& m_reg, float& mn, float& alpha) {
  constexpr float C = SCALE * 1.4426950408889634f;
  float pmax = p0[0];
#pragma unroll
  for (int r = 1; r < 16; ++r) pmax = fmaxf(pmax, p0[r]);
#pragma unroll
  for (int r = 0; r < 16; ++r) pmax = fmaxf(pmax, p1[r]);
  { auto rr = __builtin_amdgcn_permlane32_swap(__float_as_uint(pmax), __float_as_uint(pmax), false, false);
    pmax = fmaxf(__uint_as_float(rr[0]), __uint_as_float(rr[1])); }
  if (__builtin_expect(__all(pmax - m_reg <= THR / SCALE), 1)) { mn = m_reg; alpha = 1.f; }
  else { mn = fmaxf(m_reg, pmax); alpha = __builtin_amdgcn_exp2f((m_reg - mn) * C); m_reg = mn; }
  float mnC = -mn * C;
  { const f32x2 c2 = {C, C}, m2 = {mnC, mnC};
#pragma unroll
    for (int r = 0; r < 16; r += 2) { f32x2 t = {p0[r], p0[r + 1]}, u = {p1[r], p1[r + 1]};
      asm("v_pk_fma_f32 %0, %1, %2, %3" : "=v"(t) : "v"(t), "v"(c2), "v"(m2)); asm("v_pk_fma_f32 %0, %1, %2, %3" : "=v"(u) : "v"(u), "v"(c2), "v"(m2));
      p0[r] = t[0]; p0[r + 1] = t[1]; p1[r] = u[0]; p1[r + 1] = u[1]; } }
#pragma unroll
  for (int r = 0; r < 16; ++r) p0[r] = __builtin_amdgcn_exp2f(p0[r]);
}
template <int MODE>
__device__ __forceinline__ void finishSM(f32x16& p0, f32x16& p1, bf16x8& pa0, bf16x8& pa1, bf16x8& pa2, bf16x8& pa3, unsigned mw0, unsigned mw1) {
#pragma unroll
  for (int r = 0; r < 16; ++r) p1[r] = __builtin_amdgcn_exp2f(p1[r]);
#define PMSK(x, W, SH) do { if (MODE == 2) { unsigned t_; asm("v_pk_lshlrev_b16 %0, " #SH ", %1 op_sel_hi:[0,1]" : "=v"(t_) : "v"(W)); asm("v_pk_ashrrev_i16 %0, 15, %1 op_sel_hi:[0,1]" : "=v"(t_) : "v"(t_)); x &= t_; } } while (0)
#define PK4(P, BASE, OUT, W, S0, S1, S2, S3) do { unsigned a0 = cvtpk(P[BASE + 0], P[BASE + 1]), a1 = cvtpk(P[BASE + 2], P[BASE + 3]);   \
    unsigned b0 = cvtpk(P[BASE + 4], P[BASE + 5]), b1 = cvtpk(P[BASE + 6], P[BASE + 7]);                              \
    PMSK(a0, W, S0); PMSK(a1, W, S1); PMSK(b0, W, S2); PMSK(b1, W, S3);                                               \
    auto r0 = __builtin_amdgcn_permlane32_swap(a0, b0, false, false); auto r1 = __builtin_amdgcn_permlane32_swap(a1, b1, false, false); \
    u32x4 w = {r0[0], r1[0], r0[1], r1[1]}; OUT = *reinterpret_cast<bf16x8*>(&w); } while (0)
  PK4(p0, 0, pa0, mw0, 15, 14, 11, 10); PK4(p0, 8, pa1, mw0, 7, 6, 3, 2); PK4(p1, 0, pa2, mw1, 15, 14, 11, 10); PK4(p1, 8, pa3, mw1, 7, 6, 3, 2);
#undef PK4
#undef PMSK
}
__device__ __forceinline__ void qkt(f32x16& p0, f32x16& p1, const bf16* Ks, const bf16x8* qr, int r32, int hi) {
  p0 = f32x16{}; p1 = f32x16{};
#pragma unroll
  for (int d0 = 0; d0 < 8; ++d0) { int cb = (d0 * 16 + hi * 8) * 2;
    bf16x8 b0 = *reinterpret_cast<const bf16x8*>((const char*)Ks + KSWZ(r32, cb));
    bf16x8 b1 = *reinterpret_cast<const bf16x8*>((const char*)Ks + KSWZ(32 + r32, cb));
    p0 = __builtin_amdgcn_mfma_f32_32x32x16_bf16(b0, qr[d0], p0, 0, 0, 0);
    p1 = __builtin_amdgcn_mfma_f32_32x32x16_bf16(b1, qr[d0], p1, 0, 0, 0); }
}
__device__ __forceinline__ int v_st(int k, int c) { const int kk = (k & ~0xC) | ((k & 4) << 1) | ((k & 8) >> 1); return ((kk >> 3) * 4 + (c >> 5)) * 512 + ((kk & 7) * 32 + (c & 31)) * 2; }
__device__ __forceinline__ int v_rd_base(int lane) { return ((lane & 3) << 3) | (((lane >> 2) & 3) << 6) | (((lane >> 4) & 1) << 5) | (((lane >> 5) & 1) << 8); }
constexpr int v_rd_off(int d0, int ks, int half) { return d0 * 512 + ks * 4096 + half * 2048; }
template <int OFF> __device__ __forceinline__ s16x4 tr_read(int vb) {
  s16x4 r; asm volatile("ds_read_b64_tr_b16 %0, %1 offset:%2" : "=&v"(r) : "v"(vb), "i"(OFF) : "memory"); return r;
}
template <int D0> __device__ __forceinline__ void pv_one(f32x16& od, int vb, bf16x8 pa0, bf16x8 pa1, bf16x8 pa2, bf16x8 pa3) {
  const s16x4 l0 = tr_read<v_rd_off(D0, 0, 0)>(vb), h0 = tr_read<v_rd_off(D0, 0, 1)>(vb), l1 = tr_read<v_rd_off(D0, 1, 0)>(vb), h1 = tr_read<v_rd_off(D0, 1, 1)>(vb);
  const s16x4 l2 = tr_read<v_rd_off(D0, 2, 0)>(vb), h2 = tr_read<v_rd_off(D0, 2, 1)>(vb), l3 = tr_read<v_rd_off(D0, 3, 0)>(vb), h3 = tr_read<v_rd_off(D0, 3, 1)>(vb);
  asm volatile("s_waitcnt lgkmcnt(0)" ::: "memory"); SBAR();
#define PK(L, H) (bf16x8){L[0], L[1], L[2], L[3], H[0], H[1], H[2], H[3]}
  od = __builtin_amdgcn_mfma_f32_32x32x16_bf16(pa0, PK(l0, h0), od, 0, 0, 0);
  od = __builtin_amdgcn_mfma_f32_32x32x16_bf16(pa1, PK(l1, h1), od, 0, 0, 0);
  od = __builtin_amdgcn_mfma_f32_32x32x16_bf16(pa2, PK(l2, h2), od, 0, 0, 0);
  od = __builtin_amdgcn_mfma_f32_32x32x16_bf16(pa3, PK(l3, h3), od, 0, 0, 0);
#undef PK
}
__device__ __forceinline__ void pv_d0(f32x16* o, int vb, bf16x8 pa0, bf16x8 pa1, bf16x8 pa2, bf16x8 pa3) {
  const bf16x8 ones = {0x3F80, 0x3F80, 0x3F80, 0x3F80, 0x3F80, 0x3F80, 0x3F80, 0x3F80};
  o[4] = __builtin_amdgcn_mfma_f32_32x32x16_bf16(pa0, ones, o[4], 0, 0, 0); o[4] = __builtin_amdgcn_mfma_f32_32x32x16_bf16(pa1, ones, o[4], 0, 0, 0);
  o[4] = __builtin_amdgcn_mfma_f32_32x32x16_bf16(pa2, ones, o[4], 0, 0, 0); o[4] = __builtin_amdgcn_mfma_f32_32x32x16_bf16(pa3, ones, o[4], 0, 0, 0);
  pv_one<0>(o[0], vb, pa0, pa1, pa2, pa3); pv_one<1>(o[1], vb, pa0, pa1, pa2, pa3); pv_one<2>(o[2], vb, pa0, pa1, pa2, pa3); pv_one<3>(o[3], vb, pa0, pa1, pa2, pa3);
}

template <int MODE, int LDQ, int SDEPTH>
__device__ __forceinline__ void attn_unit(const bf16* __restrict__ Qb, const bf16* __restrict__ Kh, const bf16* __restrict__ Vh, bf16* __restrict__ Ob, int NT, int mp,
                                          const unsigned* __restrict__ mrow, char* lds) {
  int tid = threadIdx.x; asm volatile("" : "+v"(tid));
  const int wid = tid >> 6, lane = tid & 63, r32 = lane & 31, hi = lane >> 5, cc = wid >> 1;
  if (MODE == 2) mrow += (32 * wid + r32) * 2;
  bf16* V_lds = (bf16*)lds; bf16* K_lds = (bf16*)(lds + 2 * SHM_V);
  float* ws = (float*)(lds + SHM_WS) + wid * 64; float* al_l = ws + 32;
  const float* tbl = (const float*)(lds + SHM_TBL);
  float m_reg = -1e30f; f32x16 o[5] = {}; bf16x8 qr[8];
  const bf16* Qw = Qb + (long)(wid * QBLK + r32) * LDQ + hi * 8;
#pragma unroll
  for (int d0 = 0; d0 < 8; ++d0) qr[d0] = *reinterpret_cast<const bf16x8*>(Qw + d0 * 16);
  const int sr = tid >> 4, sc = (tid & 15) * 8, vst0 = v_st(sr, sc), vst1 = v_st(32 + sr, sc);
  const int vb0 = (int)(uintptr_t)V_lds + v_rd_base(lane);
  struct { bf16x8 vs0, vs1, ks0, ks1; } sr_[SDEPTH];
#define SLOAD(i, k0) do { sr_[i].vs0 = *reinterpret_cast<const bf16x8*>(&Vh[(long)((k0) + sr) * LDK + sc]); sr_[i].vs1 = *reinterpret_cast<const bf16x8*>(&Vh[(long)((k0) + 32 + sr) * LDK + sc]); \
    sr_[i].ks0 = *reinterpret_cast<const bf16x8*>(&Kh[(long)((k0) + sr) * LDK + sc]); sr_[i].ks1 = *reinterpret_cast<const bf16x8*>(&Kh[(long)((k0) + 32 + sr) * LDK + sc]); } while (0)
#define SWRITE(b, i) do { *(bf16x8*)((char*)V_lds + (b) * SHM_V + vst0) = sr_[i].vs0;          \
    *(bf16x8*)((char*)V_lds + (b) * SHM_V + vst1) = sr_[i].vs1; int kc = sc * 2;               \
    *(bf16x8*)((char*)K_lds + (b) * SHM_K + KSWZ(sr, kc)) = sr_[i].ks0;                       \
    *(bf16x8*)((char*)K_lds + (b) * SHM_K + KSWZ(32 + sr, kc)) = sr_[i].ks1; } while (0)
#define SWAIT() do { if (SDEPTH == 2) asm volatile("s_waitcnt vmcnt(4)" ::: "memory"); else asm volatile("s_waitcnt vmcnt(0)" ::: "memory"); } while (0)
#define RESC(a) do { if (__any((a) < 1.f)) { if (hi == 0) al_l[r32] = (a); asm volatile("s_waitcnt lgkmcnt(0)" ::: "memory"); \
    _Pragma("unroll") for (int d = 0; d < 5; ++d) _Pragma("unroll") for (int r = 0; r < 16; ++r) o[d][r] *= al_l[crow(r, hi)]; } } while (0)
#define HOOK(P0, P1, i) do { \
    if (MODE == 1) { const int trel = mp + (i); \
      if (trel < cc || trel > cc + 8) { _Pragma("unroll") for (int r = 0; r < 16; ++r) { P0[r] = -__builtin_inff(); P1[r] = -__builtin_inff(); } } \
      else { const int base = 32 * wid + r32 + 512 - 64 * trel - 4 * hi; \
        if (32 * wid + 512 - 64 * trel - 63 >= 128) { const float cb = tbl[256]; _Pragma("unroll") for (int r = 0; r < 16; ++r) { P0[r] += cb; P1[r] += cb; } } \
        else { _Pragma("unroll") for (int r = 0; r < 16; ++r) { const int c_r = (r & 3) + 8 * (r >> 2); int i0 = base - c_r, i1 = base - c_r - 32; i0 = (i0 < 128 ? i0 : 128) + 128; i1 = (i1 < 128 ? i1 : 128) + 128; \
            P0[r] += tbl[i0]; P1[r] += tbl[i1]; } } } } \
    if (MODE == 2) { if ((i) > mp + cc) { asm volatile("" ::: "memory"); _Pragma("unroll") for (int r = 0; r < 16; ++r) { P0[r] = -__builtin_inff(); P1[r] = -__builtin_inff(); } } }     \
  } while (0)
#define MLOAD(W0, W1, i) do { if (MODE == 2) { const unsigned* mpz = mrow + (size_t)(i) * 16384; W0 = mpz[0] >> (2 * hi); W1 = mpz[1] >> (2 * hi); } } while (0)
  f32x16 pA0, pA1, pB0, pB1; float mnA, mnB, alA, alB; bf16x8 pa0, pa1, pa2, pa3; unsigned mA0 = 0, mA1 = 0, mB0 = 0, mB1 = 0;
  constexpr int SE = 0, SO = SDEPTH - 1;
  SLOAD(SE, 0); MLOAD(mA0, mA1, 0); asm volatile("s_waitcnt vmcnt(0)" ::: "memory"); SWRITE(0, SE); __syncthreads();
  qkt(pA0, pA1, K_lds, qr, r32, hi); HOOK(pA0, pA1, 0); partialSM(pA0, pA1, m_reg, mnA, alA);
  SLOAD(SO, KVBLK); if (SDEPTH == 2) { if (2 < NT) SLOAD(SE, 2 * KVBLK); }
  SWAIT(); SWRITE(1, SO); __syncthreads();
  for (int j = 1; j + 1 < NT; j += 2) {
    SBAR(); qkt(pB0, pB1, (bf16*)((char*)K_lds + SHM_K), qr, r32, hi); HOOK(pB0, pB1, j);
    finishSM<MODE>(pA0, pA1, pa0, pa1, pa2, pa3, mA0, mA1); SBAR();
    MLOAD(mB0, mB1, j); SLOAD(SO, (j + SDEPTH) * KVBLK); SBAR();
    pv_d0(o, vb0, pa0, pa1, pa2, pa3); partialSM(pB0, pB1, m_reg, mnB, alB);
    __syncthreads(); SWAIT(); SWRITE(0, SE);
    RESC(alB); __syncthreads();
    SBAR(); qkt(pA0, pA1, K_lds, qr, r32, hi); HOOK(pA0, pA1, j + 1);
    finishSM<MODE>(pB0, pB1, pa0, pa1, pa2, pa3, mB0, mB1); SBAR();
    MLOAD(mA0, mA1, j + 1); if (SDEPTH == 1 || j + 3 < NT) SLOAD(SE, (j + 1 + SDEPTH) * KVBLK); SBAR();
    pv_d0(o, vb0 + (int)SHM_V, pa0, pa1, pa2, pa3); partialSM(pA0, pA1, m_reg, mnA, alA);
    __syncthreads(); SWAIT(); SWRITE(1, SO);
    RESC(alA); __syncthreads();
  }
  SBAR(); qkt(pB0, pB1, (bf16*)((char*)K_lds + SHM_K), qr, r32, hi); HOOK(pB0, pB1, NT - 1);
  finishSM<MODE>(pA0, pA1, pa0, pa1, pa2, pa3, mA0, mA1); SBAR();
  MLOAD(mB0, mB1, NT - 1);
  pv_d0(o, vb0, pa0, pa1, pa2, pa3); partialSM(pB0, pB1, m_reg, mnB, alB);
  __syncthreads(); RESC(alB);
  finishSM<MODE>(pB0, pB1, pa0, pa1, pa2, pa3, mB0, mB1); SBAR();
  pv_d0(o, vb0 + (int)SHM_V, pa0, pa1, pa2, pa3);
  float rli[16];
#pragma unroll
  for (int r = 0; r < 16; ++r) rli[r] = __builtin_amdgcn_rcpf(o[4][r]);
  bf16* Ow = Ob + (long)(wid * QBLK) * LDO;
#pragma unroll
  for (int r = 0; r < 16; ++r) { int orow = crow(r, hi);
#pragma unroll
    for (int d0 = 0; d0 < 4; ++d0) Ow[(long)orow * LDO + d0 * 32 + r32] = (bf16)f2bf(o[d0][r] * rli[r]); }
#undef SLOAD
#undef SWRITE
#undef SWAIT
#undef RESC
#undef HOOK
#undef MLOAD
}
}

__device__ __forceinline__ unsigned fkey(float f) { const unsigned u = __float_as_uint(f); return u ^ ((u >> 31) ? 0xffffffffu : 0x80000000u); }
__device__ __forceinline__ float keyf(unsigned k) { return __uint_as_float((k & 0x80000000u) ? (k ^ 0x80000000u) : ~k); }
constexpr int IDX_CAP = 512, IDX_WAVE_BYTES = 4 * IDX_CAP * 8 + 1024;
static_assert(NWAVES * IDX_WAVE_BYTES <= RING_BYTES, "indexer LDS");

__device__ __forceinline__ unsigned idx_select(const LAS u32x2* buf, int m, int lane, unsigned (&uk)[8], unsigned (&ui)[8], int slack) {
    unsigned a = 0xffffffffu, o = 0u;
#pragma unroll
    for (int j = 0; j < 8; ++j) { const int e = lane + 64 * j; u32x2 v = {0u, 0u}; if (e < m) { v = buf[e]; a &= v.x; } uk[j] = v.x; ui[j] = v.y; o |= v.x; }
#pragma unroll
    for (int sh = 1; sh < 64; sh <<= 1) { a &= (unsigned)__shfl_xor((int)a, sh); o |= (unsigned)__shfl_xor((int)o, sh); }
    const unsigned diff = (unsigned)__builtin_amdgcn_readfirstlane((int)(a ^ o)); a = (unsigned)__builtin_amdgcn_readfirstlane((int)a);
    if (diff == 0u) return a;
    const int p = 31 - __builtin_clz(diff);
    unsigned T = a & ~((2u << p) - 1u);
    int cT = m;
    for (int bit = p; bit >= 0; --bit) { const unsigned Tt = T | (1u << bit); int c = 0;
#pragma unroll
        for (int j = 0; j < 8; ++j) c += __popcll(__ballot(uk[j] >= Tt));
        if (c >= 256) { T = Tt; cT = c; }
        if (cT <= slack + 256) break; }
    return T;
}
__device__ __forceinline__ void idx_keep(unsigned T, int lane, const unsigned (&uk)[8], bool (&keep)[8]) {
    int cgt = 0;
#pragma unroll
    for (int j = 0; j < 8; ++j) cgt += __popcll(__ballot(uk[j] > T));
    const int need = 256 - cgt; int eqb = 0;
#pragma unroll
    for (int j = 0; j < 8; ++j) { const bool eq = uk[j] == T; const unsigned long long mk = __ballot(eq);
        const int rank = eqb + __builtin_amdgcn_mbcnt_hi((unsigned)(mk >> 32), __builtin_amdgcn_mbcnt_lo((unsigned)mk, 0u));
        keep[j] = uk[j] > T || (eq && rank < need); eqb += __popcll(mk); }
}
__device__ __forceinline__ unsigned idx_prune(LAS u32x2* buf, int& n, int lane) {
    unsigned uk[8], ui[8]; bool keep[8];
    const unsigned T = idx_select(buf, n, lane, uk, ui, 48);
    idx_keep(T, lane, uk, keep);
    int nn = 0;
#pragma unroll
    for (int j = 0; j < 8; ++j) { const unsigned long long mk = __ballot(keep[j]);
        const int pos = nn + __builtin_amdgcn_mbcnt_hi((unsigned)(mk >> 32), __builtin_amdgcn_mbcnt_lo((unsigned)mk, 0u));
        if (keep[j]) buf[pos] = (u32x2){uk[j], ui[j]};
        nn += __popcll(mk); }
    LDS_WAIT();
    n = nn; return T;
}
__device__ __forceinline__ void idx_append(float sc, float tau, unsigned s, int g, int lane, LAS u32x2* blo, LAS u32x2* bhi, int& nlo, int& nhi) {
    const bool pass = sc > tau; const unsigned long long mk = __ballot(pass);
    const unsigned mlo = (unsigned)mk, mhi = (unsigned)(mk >> 32), mine = g ? mhi : mlo;
    const int pos = (g ? nhi : nlo) + __popc(mine & ((1u << (lane & 31)) - 1u));
    LAS u32x2* b = g ? bhi : blo;
    if (pass) b[pos] = (u32x2){fkey(sc), s};
    nlo += __popc(mlo); nhi += __popc(mhi);
}

template <int PROBE>
__device__ __forceinline__ void indexer_phase(Frame& F, unsigned* maskw) {
    unsigned char* ws = F.ws;
    const bf16* qi = (const bf16*)(ws + WS_R1 + R1_QI); const bf16* ki = (const bf16*)(ws + WS_R1 + R1_KI); const float* wi = (const float*)(ws + WS_R1 + R1_WI);
    const int lane = F.lane, g = lane >> 5, hh = lane >> 5, rho = lane & 31;
    const int vcu = (F.G % 8 == 0) ? (F.bx % 8) * (F.G / 8) + F.bx / 8 : F.bx;
    const int gw = vcu * NWAVES + F.wave, NGW = F.G * NWAVES;
    LAS unsigned char* wl = F.lds + F.wave * IDX_WAVE_BYTES;
    LAS u32x2* B0 = (LAS u32x2*)wl; LAS u32x2* B1 = B0 + IDX_CAP; LAS u32x2* B2 = B1 + IDX_CAP; LAS u32x2* B3 = B2 + IDX_CAP;
    LAS unsigned* mrow = (LAS unsigned*)(wl + 4 * IDX_CAP * 8);
    const int a_tt = 2 * ((rho >> 2) & 1) + (rho >> 4), a_h = 4 * ((rho >> 3) & 1) + (rho & 3);
    for (int b = 0; b < NB; ++b)
    for (int uq0 = gw; uq0 < SEQ / 4; uq0 += NGW) {
        const int uq = (b & 1) ? (SEQ / 4 - 1 - uq0) : uq0;
        const int t0 = 4 * uq, chunk = t0 >> 6, n = 64 * (chunk + 1); const size_t rowbase = (size_t)b * SEQ + t0;
        if (n <= 256) {
            if (lane < 8 * (chunk + 1)) { const int T64 = lane >> 3, tt = (lane >> 1) & 3, w = lane & 1; maskw[(((size_t)b * 128 + T64) * SEQ + t0 + tt) * 2 + w] = 0xffffffffu; }
            continue; }
        bf16x8 qa[4];
#pragma unroll
        for (int s4 = 0; s4 < 4; ++s4) qa[s4] = *(const GAS bf16x8*)(qi + (rowbase + a_tt) * NIQ + a_h * 64 + hh * 32 + s4 * 8);
        const f32x8 wlo = *(const GAS f32x8*)(wi + (rowbase + 2 * g) * NIH), whi = *(const GAS f32x8*)(wi + (rowbase + 2 * g + 1) * NIH);
        int n0 = 0, n1 = 0, n2 = 0, n3 = 0; float tau0 = PROBE ? __builtin_inff() : -__builtin_inff(), tau1 = tau0;
        const bf16* kib = ki + (size_t)b * SEQ * NIK + (size_t)lane * 8;
        const int npair = n / 64;
        bf16x8 k0[8], k1[8], k2[8];
#define IDX_LOAD(K, pr) do { if (PROBE == 2 && (pr) >= 3) break; _Pragma("unroll") for (int s8 = 0; s8 < 8; ++s8) K[s8] = *(const GAS bf16x8*)(kib + ((size_t)(pr) * 2 + (s8 >> 2)) * 2048 + (s8 & 3) * 512); } while (0)
#define IDX_TILE(K, o, tile) do { f32x16 acc = {}; \
            _Pragma("unroll") for (int s4 = 0; s4 < 4; ++s4) acc = __builtin_amdgcn_mfma_f32_32x32x16_bf16(qa[s4], K[(o) + s4], acc, 0, 0, 0); \
            float sc0 = 0.f, sc1 = 0.f; \
            _Pragma("unroll") for (int i = 0; i < 8; ++i) { sc0 = fmaf(wlo[i], fmaxf(acc[i], 0.f), sc0); sc1 = fmaf(whi[i], fmaxf(acc[8 + i], 0.f), sc1); } \
            sc0 = (sc0 == 0.f) ? 0.f : sc0; sc1 = (sc1 == 0.f) ? 0.f : sc1; \
            const unsigned s = (unsigned)(32 * (tile) + rho); \
            idx_append(sc0, tau0, s, g, lane, B0, B2, n0, n2); \
            idx_append(sc1, tau1, s, g, lane, B1, B3, n1, n3); \
            if (max(max(n0, n1), max(n2, n3)) > IDX_CAP - 32) { LDS_WAIT(); \
                if (n0 > IDX_CAP - 32) { const unsigned T = idx_prune(B0, n0, lane); if (g == 0) tau0 = keyf(T); } \
                if (n2 > IDX_CAP - 32) { const unsigned T = idx_prune(B2, n2, lane); if (g == 1) tau0 = keyf(T); } \
                if (n1 > IDX_CAP - 32) { const unsigned T = idx_prune(B1, n1, lane); if (g == 0) tau1 = keyf(T); } \
                if (n3 > IDX_CAP - 32) { const unsigned T = idx_prune(B3, n3, lane); if (g == 1) tau1 = keyf(T); } } \
        } while (0)
        IDX_LOAD(k0, 0); if (1 < npair) IDX_LOAD(k1, 1); if (2 < npair) IDX_LOAD(k2, 2);
        for (int pr = 0; pr < npair; pr += 3) {
            IDX_TILE(k0, 0, 2 * pr); IDX_TILE(k0, 4, 2 * pr + 1); if (pr + 3 < npair) IDX_LOAD(k0, pr + 3);
            if (pr + 1 < npair) { IDX_TILE(k1, 0, 2 * pr + 2); IDX_TILE(k1, 4, 2 * pr + 3); if (pr + 4 < npair) IDX_LOAD(k1, pr + 4); }
            if (pr + 2 < npair) { IDX_TILE(k2, 0, 2 * pr + 4); IDX_TILE(k2, 4, 2 * pr + 5); if (pr + 5 < npair) IDX_LOAD(k2, pr + 5); }
        }
#undef IDX_LOAD
#undef IDX_TILE
        LDS_WAIT();
        if (PROBE) { if (lane == 0) maskw[rowbase] = (unsigned)(n0 + n1 + n2 + n3); continue; }
#pragma unroll
        for (int qq = 0; qq < 4; ++qq) {
            LAS u32x2* B = qq == 0 ? B0 : qq == 1 ? B1 : qq == 2 ? B2 : B3; const int m = qq == 0 ? n0 : qq == 1 ? n1 : qq == 2 ? n2 : n3;
            unsigned uk[8], ui[8]; bool keep[8]; const unsigned T = idx_select(B, m, lane, uk, ui, 0);
            idx_keep(T, lane, uk, keep);
#pragma unroll
            for (int j = 0; j < 4; ++j) mrow[lane + 64 * j] = 0u;
            LDS_WAIT();
#pragma unroll
            for (int j = 0; j < 8; ++j) { if (keep[j]) __hip_atomic_fetch_or(mrow + (ui[j] >> 5), 1u << (((ui[j] >> 1) & 15u) | ((ui[j] & 1u) << 4)), __ATOMIC_RELAXED, __HIP_MEMORY_SCOPE_WORKGROUP);     }
            LDS_WAIT();
            for (int T64 = lane; T64 <= chunk; T64 += 64) { const u32x2 wv = {mrow[2 * T64], mrow[2 * T64 + 1]};
                *(GAS u32x2*)(maskw + (((size_t)b * 128 + T64) * SEQ + t0 + qq) * 2) = wv; }
            LDS_WAIT();
        }
    }
}

__device__ __forceinline__ int block_sum_int(int v, LAS int* red, int wave, int lane, int& par) {
#pragma unroll
    for (int o = 1; o < 64; o <<= 1) v += __shfl_xor(v, o);
    LAS int* r = red + 8 * par; par ^= 1;
    if (lane == 0) r[wave] = v;
    __syncthreads();
    int s = 0;
#pragma unroll
    for (int w = 0; w < NWAVES; ++w) s += r[w];
    return s;
}
constexpr int SL_QF = 0, SL_QIF = 2048, SL_WIF = 2560, SL_RED = 2576, SL_SEL = 2592, SL_SELM = 2848, SL_SCO = 3008, SL_KP = SL_SCO + 12 * 528 + 4 * 256, SL_VP = SL_KP + 2 * 528, SL_END = SL_VP + 2 * 528;
static_assert(SL_END * 4 <= RING_BYTES, "sample LDS");
__device__ __forceinline__ void sample_task(Frame& F, int layer, int tok) {
    unsigned char* ws = F.ws; LAS float* L = (LAS float*)F.lds;
    const int tid = F.tid, lane = F.lane, wave = F.wave;
    const int sb = tok >> 4, st = tok & 15; const size_t row = (size_t)MP + tok;
    const bf16* qb = (const bf16*)(ws + WS_R1 + R1_Q) + row * NQ; const bf16* qmb = (const bf16*)(ws + WS_R1 + R1_QM) + row * NMQ;
    LAS float* qf = L + SL_QF; LAS float* qif = L + SL_QIF; LAS float* wif = L + SL_WIF; LAS int* red = (LAS int*)(L + SL_RED); LAS int* sel = (LAS int*)(L + SL_SEL);
    LAS unsigned* selm = (LAS unsigned*)(L + SL_SELM); LAS float* sco = L + SL_SCO;
    __syncthreads();
    for (int i = tid; i < 2048; i += 512) qf[i] = i < NQ ? bf2f(qb[i]) : bf2f(qmb[i - NQ]);
    if (layer == 0) { const bf16* qib = (const bf16*)(ws + WS_R1 + R1_QI) + row * NIQ; qif[tid] = bf2f(qib[tid]); if (tid < 8) wif[tid] = ((const float*)(ws + WS_R1 + R1_WI))[row * NIH + tid]; }
    if (tid < 160) selm[tid] = 0u;
    __syncthreads();
    const int nk = layer == 0 ? 256 : 528;
    if (layer == 0) {
        constexpr int LK = PAST + DS; unsigned uk[9];
#pragma unroll
        for (int j = 0; j < 9; ++j) { const int s = tid + 512 * j; uk[j] = 0u;
            if (s < LK) { const float* kr = s < PAST ? F.P->in[IN_CAI] + ((size_t)sb * PAST + s) * NIK : F.out + O_AIS + ((size_t)sb * DS + (s - PAST)) * NIK;
                float a0 = 0.f, a1 = 0.f, a2 = 0.f, a3 = 0.f, a4 = 0.f, a5 = 0.f, a6 = 0.f, a7 = 0.f;
                f32x4 tt[16];
#pragma unroll
                for (int d = 0; d < 16; ++d) tt[d] = *(const GAS f32x4*)(kr + 4 * d);
#pragma unroll
                for (int d = 0; d < 16; ++d) { const f32x4 t = tt[d]; const LAS float* qp = qif + 4 * d;
#define DOT4(A, H) A = fmaf(qp[(H) * 64 + 3], t[3], fmaf(qp[(H) * 64 + 2], t[2], fmaf(qp[(H) * 64 + 1], t[1], fmaf(qp[(H) * 64], t[0], A))))
                    DOT4(a0, 0); DOT4(a1, 1); DOT4(a2, 2); DOT4(a3, 3); DOT4(a4, 4); DOT4(a5, 5); DOT4(a6, 6); DOT4(a7, 7);
#undef DOT4
                }
                float sc = wif[0] * fmaxf(a0, 0.f); sc = fmaf(wif[1], fmaxf(a1, 0.f), sc); sc = fmaf(wif[2], fmaxf(a2, 0.f), sc); sc = fmaf(wif[3], fmaxf(a3, 0.f), sc);
                sc = fmaf(wif[4], fmaxf(a4, 0.f), sc); sc = fmaf(wif[5], fmaxf(a5, 0.f), sc); sc = fmaf(wif[6], fmaxf(a6, 0.f), sc); sc = fmaf(wif[7], fmaxf(a7, 0.f), sc);
                sc = (sc == 0.f) ? 0.f : sc; uk[j] = fkey(sc); } }
        unsigned T = 0; int par = 0;
        for (int bit = 31; bit >= 0; --bit) { const unsigned Tt = T | (1u << bit); int c = 0;
#pragma unroll
            for (int j = 0; j < 9; ++j) c += (uk[j] >= Tt) ? 1 : 0;
            if (block_sum_int(c, red, wave, lane, par) >= 256) T = Tt; }
        int cg = 0, ce = 0;
#pragma unroll
        for (int j = 0; j < 9; ++j) { cg += (uk[j] > T) ? 1 : 0; ce += (uk[j] == T) ? 1 : 0; }
        const int cgt = block_sum_int(cg, red, wave, lane, par), ceq = block_sum_int(ce, red, wave, lane, par), need = 256 - cgt;
        unsigned X = 0xffffffffu;
        if (need < ceq) { X = 0;
            for (int bit = 12; bit >= 0; --bit) { const unsigned Xt = X | (1u << bit); int c = 0;
#pragma unroll
                for (int j = 0; j < 9; ++j) c += (uk[j] == T && (unsigned)(tid + 512 * j) < Xt) ? 1 : 0;
                if (block_sum_int(c, red, wave, lane, par) < need) X = Xt; } }
#pragma unroll
        for (int j = 0; j < 9; ++j) { const unsigned s = (unsigned)(tid + 512 * j); if (uk[j] > T || (uk[j] == T && uk[j] != 0u && s <= X)) __hip_atomic_fetch_or(selm + (s >> 5), 1u << (s & 31u), __ATOMIC_RELAXED, __HIP_MEMORY_SCOPE_WORKGROUP); }
        __syncthreads();
        if (tid < 129) { int pos = 0; for (int w = 0; w < tid; ++w) pos += __popc(selm[w]); unsigned mw = selm[tid]; while (mw) { const int bpos = __builtin_ctz(mw); mw &= mw - 1u; if (pos < 256) sel[pos] = 32 * tid + bpos; ++pos; } }
        __syncthreads();
    }
    LAS unsigned long long* kpt = (LAS unsigned long long*)(L + SL_KP); LAS unsigned long long* vpt = (LAS unsigned long long*)(L + SL_VP);
    for (int jx = tid; jx < nk; jx += 512) { const float *kr, *vr;
        if (layer == 0) { const int s = sel[jx];
            if (s < PAST) { kr = F.P->in[IN_CAK] + ((size_t)sb * PAST + s) * 512; vr = F.P->in[IN_CAV] + ((size_t)sb * PAST + s) * 512; }
            else { kr = F.out + O_AKS + ((size_t)sb * DS + (s - PAST)) * 512; vr = F.out + O_AVS + ((size_t)sb * DS + (s - PAST)) * 512; } }
        else { if (jx < BBUF) { kr = F.P->in[IN_CBK] + ((size_t)sb * BBUF + jx) * 512; vr = F.P->in[IN_CBV] + ((size_t)sb * BBUF + jx) * 512; }
            else { kr = F.out + O_BKS + ((size_t)sb * BBUF + (BBUF - DS) + (jx - BBUF)) * 512; vr = F.out + O_BVS + ((size_t)sb * BBUF + (BBUF - DS) + (jx - BBUF)) * 512; } }
        kpt[jx] = (unsigned long long)(uintptr_t)kr; vpt[jx] = (unsigned long long)(uintptr_t)vr; }
    __syncthreads();
    const int ntok = 12 * nk, ngk = 4 * nk, ntot = ngk + 4 * NMEM;
    for (int p = tid; p < ntot; p += 512) {
        const float* kr; int h, jx;
        if (p < ngk) { const int gk = p / nk; jx = p - gk * nk; h = 3 * gk; kr = (const float*)(uintptr_t)kpt[jx] + gk * 128; }
        else { const int pm = p - ngk; h = 12 + (pm >> 8); jx = pm & 255; kr = F.P->in[IN_CMK] + ((((size_t)layer * DB + sb) * NMEM + jx) * 4 + (h - 12)) * 128; }
        f32x4 tr[32];
#pragma unroll
        for (int d = 0; d < 32; ++d) tr[d] = *(const GAS f32x4*)(kr + 4 * d);
        if (h < 12) { float a0 = 0.f, a1 = 0.f, a2 = 0.f;
#pragma unroll
            for (int d = 0; d < 32; ++d) { const f32x4 t = tr[d]; const LAS float* q0 = qf + h * 128 + 4 * d;
                a0 = fmaf(q0[0], t[0], a0); a0 = fmaf(q0[1], t[1], a0); a0 = fmaf(q0[2], t[2], a0); a0 = fmaf(q0[3], t[3], a0);
                a1 = fmaf(q0[128], t[0], a1); a1 = fmaf(q0[129], t[1], a1); a1 = fmaf(q0[130], t[2], a1); a1 = fmaf(q0[131], t[3], a1);
                a2 = fmaf(q0[256], t[0], a2); a2 = fmaf(q0[257], t[1], a2); a2 = fmaf(q0[258], t[2], a2); a2 = fmaf(q0[259], t[3], a2); }
            float b0 = 0.f, b1 = 0.f, b2 = 0.f;
            if (layer == 1) { const int kp = jx < BBUF ? PAST - BBUF + jx : PAST + (jx - BBUF); int rel = (PAST + st) - kp; rel = rel < -128 ? -128 : (rel > 128 ? 128 : rel);
                const float* rb = F.P->in[IN_RELB] + h * 257 + rel + 128; b0 = rb[0]; b1 = rb[257]; b2 = rb[514]; }
            sco[h * nk + jx] = a0 * ATT_SCALE + b0; sco[(h + 1) * nk + jx] = a1 * ATT_SCALE + b1; sco[(h + 2) * nk + jx] = a2 * ATT_SCALE + b2; }
        else { float a = 0.f;
#pragma unroll
            for (int d = 0; d < 32; ++d) { const f32x4 t = tr[d]; const LAS float* q0 = qf + h * 128 + 4 * d; a = fmaf(q0[0], t[0], a); a = fmaf(q0[1], t[1], a); a = fmaf(q0[2], t[2], a); a = fmaf(q0[3], t[3], a); }
            sco[ntok + (h - 12) * NMEM + jx] = a * ATT_SCALE; }
    }
    __syncthreads();
    for (int h = wave; h < 16; h += NWAVES) { const int cnt = h < 12 ? nk : NMEM; LAS float* sp = sco + (h < 12 ? h * nk : ntok + (h - 12) * NMEM);
        float mx = -__builtin_inff(); for (int i = lane; i < cnt; i += 64) mx = fmaxf(mx, sp[i]); mx = wave_max(mx);
        float sm = 0.f; for (int i = lane; i < cnt; i += 64) { const float e = __expf(sp[i] - mx); sp[i] = e; sm += e; } sm = wave_sum(sm);
        const float inv = 1.f / sm; for (int i = lane; i < cnt; i += 64) sp[i] *= inv; }
    __syncthreads();
    bf16* ao = (bf16*)(ws + WS_R1 + R1_AO) + row * DM;
    { const int grp = tid >> 5, d4 = (tid & 31) * 4, slice = grp & 1; f32x4 a0 = {0.f, 0.f, 0.f, 0.f}, a1 = a0, a2 = a0;
      const int hb = grp < 8 ? 3 * (grp >> 1) : 12 + ((grp - 8) >> 1);
      if (grp < 8) { const int gk = grp >> 1; const LAS float* sp = sco + hb * nk;
#pragma unroll 1
          for (int j0 = 16 * slice; j0 < nk; j0 += 32) { f32x4 vv[16];
#pragma unroll
              for (int u = 0; u < 16; ++u) vv[u] = *(const GAS f32x4*)((const float*)(uintptr_t)vpt[j0 + u] + gk * 128 + d4);
#pragma unroll
              for (int u = 0; u < 16; ++u) { a0 += vv[u] * sp[j0 + u]; a1 += vv[u] * sp[nk + j0 + u]; a2 += vv[u] * sp[2 * nk + j0 + u]; } } }
      else { const LAS float* sp = sco + ntok + (hb - 12) * NMEM; const float* vb = F.P->in[IN_CMV] + ((((size_t)layer * DB + sb) * NMEM) * 4 + (hb - 12)) * 128 + d4;
#pragma unroll 1
          for (int j0 = 16 * slice; j0 < NMEM; j0 += 32) { f32x4 vv[16];
#pragma unroll
              for (int u = 0; u < 16; ++u) vv[u] = *(const GAS f32x4*)(vb + (size_t)(j0 + u) * 512);
#pragma unroll
              for (int u = 0; u < 16; ++u) a0 += vv[u] * sp[j0 + u]; } }
      LAS float* part = qf + hb * 128 + d4;
      if (slice) { *(LAS f32x4*)part = a0; if (grp < 8) { *(LAS f32x4*)(part + 128) = a1; *(LAS f32x4*)(part + 256) = a2; } }
      __syncthreads();
      if (!slice) { a0 += *(const LAS f32x4*)part; u32x2 o; o.x = pk2(a0[0], a0[1]); o.y = pk2(a0[2], a0[3]); *(GAS u32x2*)(ao + hb * 128 + d4) = o;
          if (grp < 8) { a1 += *(const LAS f32x4*)(part + 128); a2 += *(const LAS f32x4*)(part + 256);
              o.x = pk2(a1[0], a1[1]); o.y = pk2(a1[2], a1[3]); *(GAS u32x2*)(ao + (hb + 1) * 128 + d4) = o;
              o.x = pk2(a2[0], a2[1]); o.y = pk2(a2[2], a2[3]); *(GAS u32x2*)(ao + (hb + 2) * 128 + d4) = o; } } }
    __syncthreads();
}

#ifdef DBG_CHECK
__device__ __forceinline__ void dbg_token_task(Frame& F, int layer, int b, int t, float* acc) {
    int dpar_ = 0;
    unsigned char* ws = F.ws; LAS float* L = (LAS float*)F.lds;
    const int tid = F.tid, lane = F.lane, wave = F.wave;
    const size_t row = (size_t)b * SEQ + t; const size_t brow = (size_t)b * SEQ;
    const bf16* qb = (const bf16*)(ws + WS_R1 + R1_Q) + row * NQ; const bf16* qmb = (const bf16*)(ws + WS_R1 + R1_QM) + row * NMQ;
    const bf16* kbuf = (const bf16*)(ws + WS_R1 + R1_K); const bf16* vbuf = (const bf16*)(ws + WS_R1 + R1_V); const bf16* kibuf = (const bf16*)(ws + WS_R1 + R1_KI);
    const bf16* mkb = (const bf16*)(ws + WS_MKB) + ((size_t)layer * 1024 + (size_t)b * NMEM) * 512; const bf16* mvb = (const bf16*)(ws + WS_MVB) + ((size_t)layer * 1024 + (size_t)b * NMEM) * 512;
    LAS float* qf = L + SL_QF; LAS float* qif = L + SL_QIF; LAS float* wif = L + SL_WIF; LAS int* red = (LAS int*)(L + SL_RED); LAS int* sel = (LAS int*)(L + SL_SEL);
    LAS unsigned* selm = (LAS unsigned*)(L + 16384); LAS float* sco = L + SL_SCO;
    __syncthreads();
    for (int i = tid; i < 2048; i += 512) qf[i] = i < NQ ? bf2f(qb[i]) : bf2f(qmb[i - NQ]);
    if (layer == 0) { const bf16* qib = (const bf16*)(ws + WS_R1 + R1_QI) + row * NIQ; qif[tid] = bf2f(qib[tid]); if (tid < 8) wif[tid] = ((const float*)(ws + WS_R1 + R1_WI))[row * NIH + tid]; }
    if (tid < 256) selm[tid] = 0u;
    __syncthreads();
    const int chunk = t >> 6;
    int nk, key0 = 0;
    if (layer == 0) {
        const int n = 64 * (chunk + 1);
        LAS unsigned* ukl = (LAS unsigned*)(L + 20000);
#pragma unroll 1
        for (int s = tid; s < n; s += 512) { float sc = 0.f;
#pragma unroll 1
            for (int h = 0; h < 8; ++h) { float a = 0.f;
#pragma unroll 4
                for (int d = 0; d < 64; ++d) a = fmaf(qif[h * 64 + d], bf2f(kibuf[ki_tiled(brow + s, d)]), a);
                sc = fmaf(wif[h], fmaxf(a, 0.f), sc); }
            sc = (sc == 0.f) ? 0.f : sc; ukl[s] = fkey(sc); }
        __syncthreads();
        if (n <= 256) {
#pragma unroll 1
            for (int s = tid; s < n; s += 512) __hip_atomic_fetch_or(selm + (s >> 5), 1u << (s & 31), __ATOMIC_RELAXED, __HIP_MEMORY_SCOPE_WORKGROUP);
            nk = n;
        } else {
            unsigned T = 0;
#pragma unroll 1
            for (int bit = 31; bit >= 0; --bit) { const unsigned Tt = T | (1u << bit); int c = 0;
#pragma unroll 1
                for (int s = tid; s < n; s += 512) c += (ukl[s] >= Tt) ? 1 : 0;
                if (block_sum_int(c, red, wave, lane, dpar_) >= 256) T = Tt; }
            int cg = 0, ce = 0;
#pragma unroll 1
            for (int s = tid; s < n; s += 512) { cg += (ukl[s] > T) ? 1 : 0; ce += (ukl[s] == T) ? 1 : 0; }
            const int cgt = block_sum_int(cg, red, wave, lane, dpar_), ceq = block_sum_int(ce, red, wave, lane, dpar_), need = 256 - cgt;
            unsigned X = 0xffffffffu;
            if (need < ceq) { X = 0;
#pragma unroll 1
                for (int bit = 12; bit >= 0; --bit) { const unsigned Xt = X | (1u << bit); int c = 0;
#pragma unroll 1
                    for (int s = tid; s < n; s += 512) c += (ukl[s] == T && (unsigned)s < Xt) ? 1 : 0;
                    if (block_sum_int(c, red, wave, lane, dpar_) < need) X = Xt; } }
#pragma unroll 1
            for (int s = tid; s < n; s += 512) { const unsigned u = ukl[s]; if (u > T || (u == T && (unsigned)s <= X)) __hip_atomic_fetch_or(selm + (s >> 5), 1u << (s & 31), __ATOMIC_RELAXED, __HIP_MEMORY_SCOPE_WORKGROUP); }
            nk = 256;
        }
        __syncthreads();
        if (tid < 256) { int pos = 0; for (int w = 0; w < tid; ++w) pos += __popc(selm[w]); unsigned mw = selm[tid]; while (mw) { const int bpos = __builtin_ctz(mw); mw &= mw - 1u; if (pos < 256) sel[pos] = 32 * tid + bpos; ++pos; } }
        __syncthreads();
    } else { key0 = 64 * chunk - 512; if (key0 < 0) key0 = 0; nk = 64 * chunk + 64 - key0; }
    const int ntok = 12 * nk, ntot = ntok + 4 * NMEM;
    for (int p = tid; p < ntot; p += 512) {
        const bf16* kr; int h; float bias = 0.f;
        if (p < ntok) { h = p / nk; const int jx = p - h * nk, gk = h / 3; const int s = layer == 0 ? sel[jx] : key0 + jx; kr = kbuf + (brow + s) * NKV + gk * 128;
            if (layer == 1) { int rel = t - s; rel = rel < -128 ? -128 : (rel > 128 ? 128 : rel); bias = F.P->in[IN_RELB][h * 257 + rel + 128]; } }
        else { const int pm = p - ntok; h = 12 + (pm >> 8); kr = mkb + (size_t)(pm & 255) * 512 + (h - 12) * 128; }
        float a = 0.f; for (int d = 0; d < 128; ++d) a = fmaf(qf[h * 128 + d], bf2f(kr[d]), a);
        sco[p] = a * ATT_SCALE + bias;
    }
    __syncthreads();
    for (int h = wave; h < 16; h += NWAVES) { const int cnt = h < 12 ? nk : NMEM; LAS float* sp = sco + (h < 12 ? h * nk : ntok + (h - 12) * NMEM);
        float mx = -__builtin_inff(); for (int i = lane; i < cnt; i += 64) mx = fmaxf(mx, sp[i]); mx = wave_max(mx);
        float sm = 0.f; for (int i = lane; i < cnt; i += 64) { const float e = __expf(sp[i] - mx); sp[i] = e; sm += e; } sm = wave_sum(sm);
        const float inv = 1.f / sm; for (int i = lane; i < cnt; i += 64) sp[i] *= inv; }
    __syncthreads();
    const bf16* ao = (const bf16*)(ws + WS_R1 + R1_AO) + row * DM;
    float d2t = 0.f, r2t = 0.f, d2m = 0.f, r2m = 0.f;
#pragma unroll 1
    for (int i = 0; i < 4; ++i) { const int idx = tid + 512 * i, h = idx >> 7, d = idx & 127; float a = 0.f;
        if (h < 12) { const int gk = h / 3; const LAS float* sp = sco + h * nk;
            for (int jx = 0; jx < nk; ++jx) { const int s = layer == 0 ? sel[jx] : key0 + jx; a = fmaf(sp[jx], bf2f(vbuf[(brow + s) * NKV + gk * 128 + d]), a); } }
        else { const LAS float* sp = sco + ntok + (h - 12) * NMEM; for (int jx = 0; jx < NMEM; ++jx) a = fmaf(sp[jx], bf2f(mvb[(size_t)jx * 512 + (h - 12) * 128 + d]), a); }
        const float got = bf2f(ao[idx]), df = got - a;
        if (h < 12) { d2t += df * df; r2t += a * a; } else { d2m += df * df; r2m += a * a; } }
    d2t = wave_sum(d2t); r2t = wave_sum(r2t); d2m = wave_sum(d2m); r2m = wave_sum(r2m);
    if (lane == 0) { atomicAdd(acc + 0, d2t); atomicAdd(acc + 1, r2t); atomicAdd(acc + 2, d2m); atomicAdd(acc + 3, r2m); }
    __syncthreads();
}
#endif

#ifndef REPEAT_MASK
#define REPEAT_MASK 0
#endif
#define NREP(bit) ((REPEAT_MASK >> (bit)) & 1 ? 2 : 1)
#ifndef ATT_SD
#define ATT_SD 1
#endif
__device__ __forceinline__ int vcu_of(const Frame& F) { return (F.G % 8 == 0) ? (F.bx % 8) * (F.G / 8) + F.bx / 8 : F.bx; }
__device__ __forceinline__ void mem_units(Frame& F, int layer) {
    unsigned char* ws = F.ws; char* lds = (char*)F.lds;
    const bf16* qm = (const bf16*)(ws + WS_R1 + R1_QM); bf16* ao = (bf16*)(ws + WS_R1 + R1_AO);
    const bf16* mkb = (const bf16*)(ws + WS_MKB) + (size_t)layer * 1024 * 512; const bf16* mvb = (const bf16*)(ws + WS_MVB) + (size_t)layer * 1024 * 512;
    if (F.bx < F.G / 2) return;
    for (int u = F.bx - F.G / 2; u < NB * 4 * 32; u += F.G - F.G / 2) {
        const int j = u & 31, hm = (u >> 5) & 3, b = u >> 7; const size_t row0 = (size_t)b * SEQ + 256 * j;
        att::attn_unit<0, NMQ, ATT_SD>(qm + row0 * NMQ + hm * 128, mkb + (size_t)b * NMEM * 512 + hm * 128, mvb + (size_t)b * NMEM * 512 + hm * 128, ao + row0 * DM + NQ + hm * 128, NMEM / 64, 0, nullptr, lds);
    }
}
template <int MODE>
__device__ __forceinline__ void dsa_units(Frame& F, bf16* ao) {
    unsigned char* ws = F.ws; char* lds = (char*)F.lds;
    const bf16* q = (const bf16*)(ws + WS_R1 + R1_Q); const bf16* k = (const bf16*)(ws + WS_R1 + R1_K); const bf16* v = (const bf16*)(ws + WS_R1 + R1_V);
    const unsigned* maskw = (const unsigned*)(ws + WS_MASK);
    for (int p = vcu_of(F); p < NB * 12 * 16; p += F.G) {
        const int s = p & 15, bh = p >> 4, h3 = bh % 3, bg = bh / 3, gk = bg & 3, b = bg >> 2, h = gk * 3 + h3;
#pragma unroll 1
        for (int half = 0; half < 2; ++half) { const int j = half ? 31 - s : s; const size_t row0 = (size_t)b * SEQ + 256 * j;
            const unsigned* mrow = maskw + (((size_t)b * 128) * SEQ + 256 * j) * 2;
            att::attn_unit<MODE, NQ, ATT_SD>(q + row0 * NQ + h * 128, k + (size_t)b * SEQ * NKV + gk * 128, v + (size_t)b * SEQ * NKV + gk * 128, ao + row0 * DM + h * 128, 4 * (j + 1), 4 * j, mrow, lds); }
    }
}
__device__ __forceinline__ void attn_phase_A(Frame& F) {
    for (int rep_ = 0; rep_ < NREP(5); ++rep_) if (F.bx < MS) sample_task(F, 0, F.bx);
    dsa_units<2>(F, (bf16*)(F.ws + WS_R1 + R1_AO));
    mem_units(F, 0);
}
__device__ __forceinline__ void attn_phase_B(Frame& F) {
    unsigned char* ws = F.ws; char* lds = (char*)F.lds;
    for (int rep_ = 0; rep_ < NREP(5); ++rep_) if (F.bx < MS) sample_task(F, 1, F.bx);
    const bf16* q = (const bf16*)(ws + WS_R1 + R1_Q); const bf16* k = (const bf16*)(ws + WS_R1 + R1_K); const bf16* v = (const bf16*)(ws + WS_R1 + R1_V); bf16* ao = (bf16*)(ws + WS_R1 + R1_AO);
    float* tbl = (float*)(lds + att::SHM_TBL);
    for (int u = vcu_of(F); u < NB * 12 * 32; u += F.G) {
        const int j = u & 31, bh = u >> 5, h3 = bh % 3, bg = bh / 3, gk = bg & 3, b = bg >> 2, h = gk * 3 + h3;
        const int t0 = j >= 2 ? 0 : 8 - 4 * j;
        const size_t row0 = (size_t)b * SEQ + 256 * j; const long key0 = (long)256 * j - 512 + 64 * t0;
        __syncthreads();
        if (F.tid < 257) tbl[F.tid] = F.P->in[IN_RELB][h * 257 + F.tid] * (1.0f / ATT_SCALE);
        __syncthreads();
        att::attn_unit<1, NQ, ATT_SD>(q + row0 * NQ + h * 128, k + ((size_t)b * SEQ + key0) * NKV + gk * 128, v + ((size_t)b * SEQ + key0) * NKV + gk * 128, ao + row0 * DM + h * 128, 12 - t0, t0, nullptr, lds);
    }
    mem_units(F, 1);
}


#ifndef SK_SW_RB
#define SK_SW_RB 8
#endif
__device__ __forceinline__ void sk_swiglu(Frame& F, const bf16* Wt, const float* st, const float* cb, int ln) { unsigned char* ws = F.ws;
    for (int wg = F.bx; wg < 256; wg += F.G) { SkMapSwiglu rm{22 * wg}; SkEpiSwiglu ep{(bf16*)(ws + WS_R1), 22 * wg, st, cb, ln};
        skinny_gemm<4, SK_SW_RB, 8 / SK_SW_RB>((const bf16*)(ws + WS_X) + (size_t)MP * DM, DM, Wt, DM, rm, ep, (LAS float*)F.lds, wg, 0); } }
__device__ __forceinline__ void sk_resid(Frame& F, const bf16* A, int K, const bf16* Wt, float cs, const float* sto, const float* g, const float* b, float* stn, int ln) { unsigned char* ws = F.ws;
    for (int wg = F.bx; wg < 256; wg += F.G) { const int mi = wg & 3, ni = wg >> 2; SkMapLinear2 rm{32 * ni}; SkEpiResid ep{(bf16*)(ws + WS_X), 32 * ni, cs, ALPHA, sto, g, b, stn, ln};
        skinny_gemm<2, 2, 1>(A, K, Wt, K, rm, ep, (LAS float*)F.lds, wg, 32 * mi); } }
__device__ __forceinline__ void sk_inb(Frame& F, const float* st, const float* cb) { unsigned char* ws = F.ws;
    for (int wg = F.bx; wg < 256; wg += F.G) { SkMapLinear rm{12 * wg, 12}; SkEpiInB ep{ws, F.out, 12 * wg, st, cb};
        skinny_gemm<1, 8, 1>((const bf16*)(ws + WS_X) + (size_t)MP * DM, DM, (const bf16*)(ws + WS_WINB), DM, rm, ep, (LAS float*)F.lds, wg, 0); } }
__device__ __forceinline__ void sk_ina(Frame& F, const float* st, const float* cb) { unsigned char* ws = F.ws;
    for (int wg = F.bx; wg < 256; wg += F.G) { SkMapInA rm{wg}; SkEpiInA ep{ws, F.out, wg, st, cb};
        skinny_gemm<2, 8, 1>((const bf16*)(ws + WS_X) + (size_t)MP * DM, DM, (const bf16*)(ws + WS_WINA), DM, rm, ep, (LAS float*)F.lds, wg, 0); } }

#define PG8_SP2 true
#define PG8_ALIGN true
enum { PH_PRO = 0, PH_MEM, PH_L0, PH_PER_LAYER = 11, PH_END = PH_L0 + 2 * PH_PER_LAYER };

__global__ void __launch_bounds__(NWAVES * 64, 2) fwd_kernel(Params args) {
    extern __shared__ __attribute__((aligned(16))) unsigned char lds[];
    Frame F;
    F.lds = (LAS unsigned char*)lds;
    F.tid = threadIdx.x; F.lane = F.tid & 63; F.wave = __builtin_amdgcn_readfirstlane(F.tid >> 6);
    F.G = gridDim.x; F.bx = blockIdx.x;
    F.P = &args;
    F.out = args.out; F.ws = args.ws;
    for (int u = F.tid; u < (LDS_BYTES - LDSCTL_OFF) / 4; u += NWAVES * 64) ((LAS unsigned*)(F.lds + LDSCTL_OFF))[u] = 0u;
    __syncthreads();
    volatile LAS unsigned* MISC = (volatile LAS unsigned*)(F.lds + MISC_OFF);
    (void)xcd_barrier_post((unsigned*)(args.ws + WS_CTL) + CW_BAR, MISC + 8);
#ifdef MK_CUTS
    const int lo = args.ph_lo, hi = args.ph_hi;
#else
    constexpr int lo = 0, hi = PH_END;
#endif
#define IN(k) (lo <= (k) && (k) < hi)
#define SEAM(k) do { if (IN((k) + 1)) { XcdBarrier bb_; GAS unsigned* bw_ = (GAS unsigned*)(args.ws + WS_CTL) + CW_BAR; asm volatile("" : "+s"(bw_)); bb_.bar = (unsigned*)bw_; bb_.x = xb_xcc_id(); bb_.st = MISC + 8; xcd_barrier(bb_); } } while (0)
    PG8_LAS unsigned char* glds = (PG8_LAS unsigned char*)lds;
#define PHASE_BEGIN() { int t_ = threadIdx.x; asm volatile("" : "+v"(t_)); F.tid = t_; F.lane = t_ & 63; F.wave = __builtin_amdgcn_readfirstlane(t_ >> 6); int b_ = blockIdx.x, g_ = gridDim.x; asm volatile("" : "+s"(b_), "+s"(g_)); F.bx = b_; F.G = g_; } GAS unsigned char* wsg_ = (GAS unsigned char*)args.ws; asm volatile("" : "+s"(wsg_)); unsigned char* ws = (unsigned char*)wsg_; F.ws = ws; GAS float* og_ = (GAS float*)args.out; asm volatile("" : "+s"(og_)); F.out = (float*)og_;     bf16* X = (bf16*)(ws + WS_X); bf16* H = (bf16*)(ws + WS_R1); (void)X; (void)H

    for (int rep_ = 0; rep_ < NREP(0); ++rep_) if (IN(PH_PRO)) { PHASE_BEGIN(); p0_prologue(F); SEAM(PH_PRO); }
#pragma unroll 1
    for (int l = 0; l < 2; ++l) {
        const int P = PH_L0 + l * PH_PER_LAYER;
#define ST(i) ((float*)(ws + WS_STATS) + (size_t)(i) * MPAD * 2)
#define CB(m) ((const float*)(ws + CTL_CSBW) + (size_t)(m) * CSBW_STRIDE)
#define LG(i) (F.P->in[IN_LNG] + (size_t)(i) * DM)
#define LB(i) (F.P->in[IN_LNB] + (size_t)(i) * DM)
        for (int rep_ = 0; rep_ < (l == 0 ? NREP(4) : 1); ++rep_) if (IN(P + 0)) { PHASE_BEGIN(); const bf16* W = (const bf16*)(ws + WS_WFI + (size_t)(2 * l) * 44 * MiB);
            const float* st = ST(2); const float* cb = CB(FM_F1L1);
            pg8::Gemm g{X, W, MP, NFF2, DM}; pg8::StaticOrder S; S.init(MP, NFF2, F.G, F.bx); if (l) stats_finalize_local(F, S, (const float*)(ws + WS_STATP), ST(2)); sk_swiglu(F, W, st, cb, l);
            pg8::EpiSwiglu E{H, st, cb, l}; pg8::gemm_phase<pg8::EpiSwiglu, pg8::StaticOrder, PG8_ALIGN, PG8_SP2>(glds, g, S, E); SEAM(P + 0); }
        if (IN(P + 1)) { PHASE_BEGIN(); const bf16* W = (const bf16*)(ws + WS_WFO + (size_t)(2 * l) * 22 * MiB);
            const float* sto = ST(2); float* stn = ST(3 * l);
            sk_resid(F, H + (size_t)MP * DFF, DFF, W, 0.5f, sto, LG(2), LB(2), stn, l); pg8::Gemm g{H, W, MP, DM, DFF}; pg8::StaticOrder S; S.init(MP, DM, F.G, F.bx);
            pg8::EpiResid E{X, 0.5f, ALPHA, sto, LG(2), LB(2), (float*)(ws + WS_STATP), l}; pg8::gemm_phase<pg8::EpiResid, pg8::StaticOrder, PG8_ALIGN, PG8_SP2>(glds, g, S, E); SEAM(P + 1); }
        if (l == 0) {
            if (IN(P + 3)) { PHASE_BEGIN(); pg8::Gemm g{X, (const bf16*)(ws + WS_WINA), MP, PROJ_A_PAD, DM}; pg8::StaticOrder S; S.init(MP, PROJ_A_PAD, F.G, F.bx); stats_finalize_local(F, S, (const float*)(ws + WS_STATP), ST(0)); sk_ina(F, ST(0), CB(FM_INA));
                pg8::EpiInA E{ws, F.out, ST(0), CB(FM_INA)};
                pg8::gemm_phase<pg8::EpiInA, pg8::StaticOrder, PG8_ALIGN, PG8_SP2>(glds, g, S, E);
                {
                  pg8::Gemm g2{(const bf16*)(ws + WS_MEMB), (const bf16*)(ws + WS_WMEM), NB * NMEM, 2048, DM}; pg8::StaticOrder S2; S2.init(NB * NMEM, 2048, F.G, (F.bx + F.G / 2) % F.G);
                  pg8::EpiMem E2{F.out + O_MK, F.out + O_MV, (bf16*)(ws + WS_MKB), (bf16*)(ws + WS_MVB)};
                  pg8::gemm_phase<pg8::EpiMem, pg8::StaticOrder, PG8_ALIGN, PG8_SP2>(glds, g2, S2, E2); }
                SEAM(P + 3); }
            for (int rep_ = 0; rep_ < NREP(1); ++rep_) if (IN(P + 4)) { PHASE_BEGIN(); indexer_phase<0>(F, (unsigned*)(ws + WS_MASK)); SEAM(P + 4); }
            for (int rep_ = 0; rep_ < NREP(2); ++rep_) if (IN(P + 5)) { PHASE_BEGIN(); attn_phase_A(F); SEAM(P + 5); }
#ifdef SHADOW
            if (IN(P + 5)) { PHASE_BEGIN();
#if SHADOW == 1
                dsa_units<2>(F, (bf16*)(F.out + O_YP));
#elif SHADOW == 2
                dsa_units<0>(F, (bf16*)(F.out + O_YP));
#elif SHADOW == 4
                indexer_phase<1>(F, (unsigned*)(F.out + O_YP));
#elif SHADOW == 5
                indexer_phase<2>(F, (unsigned*)(F.out + O_YP));
#endif
                SEAM(P + 5); }
#endif
        } else {
            if (IN(P + 3)) { PHASE_BEGIN(); pg8::Gemm g{X, (const bf16*)(ws + WS_WINB), MP, PROJ_B, DM}; pg8::StaticOrder S; S.init(MP, PROJ_B, F.G, F.bx); stats_finalize_local(F, S, (const float*)(ws + WS_STATP), ST(3)); sk_inb(F, ST(3), CB(FM_INB));
                pg8::EpiInB E{ws, F.out, ST(3), CB(FM_INB)};
                pg8::gemm_phase<pg8::EpiInB, pg8::StaticOrder, PG8_ALIGN, PG8_SP2>(glds, g, S, E); SEAM(P + 3); }
            for (int rep_ = 0; rep_ < NREP(3); ++rep_) if (IN(P + 5)) { PHASE_BEGIN(); attn_phase_B(F); SEAM(P + 5); }
        }
#ifdef DBG_CHECK
        if (IN(P + 6)) { PHASE_BEGIN(); if (F.bx < 256) { const int b_ = F.bx & 3, t_ = (((F.bx >> 2) * 131 + 7) & (SEQ - 1)); dbg_token_task(F, l, b_, t_, (float*)(ws + WS_CTL) + 1024 + 4 * l); } }
#endif
        if (IN(P + 6)) { PHASE_BEGIN(); const bf16* W = (const bf16*)(ws + WS_WO + (size_t)l * 8 * MiB); const float* sto = ST(3 * l); float* stn = ST(3 * l + 1);
            sk_resid(F, (const bf16*)(ws + WS_R1 + R1_AO) + (size_t)MP * DM, DM, W, 1.0f, sto, LG(3 * l), LB(3 * l), stn, 1);
            pg8::Gemm g{(const bf16*)(ws + WS_R1 + R1_AO), W, MP, DM, DM}; pg8::StaticOrder S; S.init(MP, DM, F.G, F.bx);
            pg8::EpiResid E{X, 1.0f, ALPHA, sto, LG(3 * l), LB(3 * l), (float*)(ws + WS_STATP), 1}; pg8::gemm_phase<pg8::EpiResid, pg8::StaticOrder, PG8_ALIGN, PG8_SP2>(glds, g, S, E); SEAM(P + 6); }
        if (IN(P + 8)) { PHASE_BEGIN(); const bf16* W = (const bf16*)(ws + WS_WFI + (size_t)(2 * l + 1) * 44 * MiB); const float* st = ST(3 * l + 1); const float* cb = CB(l ? FM_F2L1 : FM_F2L0);
            pg8::Gemm g{X, W, MP, NFF2, DM}; pg8::StaticOrder S; S.init(MP, NFF2, F.G, F.bx); stats_finalize_local(F, S, (const float*)(ws + WS_STATP), ST(3 * l + 1)); sk_swiglu(F, W, st, cb, 1);
            pg8::EpiSwiglu E{H, st, cb, 1}; pg8::gemm_phase<pg8::EpiSwiglu, pg8::StaticOrder, PG8_ALIGN, PG8_SP2>(glds, g, S, E); SEAM(P + 8); }
        if (IN(P + 9)) { PHASE_BEGIN(); const bf16* W = (const bf16*)(ws + WS_WFO + (size_t)(2 * l + 1) * 22 * MiB); const float* sto = ST(3 * l + 1); float* stn = ST(3 * l + 2);
            sk_resid(F, H + (size_t)MP * DFF, DFF, W, 0.5f, sto, LG(3 * l + 1), LB(3 * l + 1), stn, 1); pg8::Gemm g{H, W, MP, DM, DFF}; pg8::StaticOrder S; S.init(MP, DM, F.G, F.bx);
            pg8::EpiResid E{X, 0.5f, ALPHA, sto, LG(3 * l + 1), LB(3 * l + 1), (float*)(ws + WS_STATP), 1}; pg8::gemm_phase<pg8::EpiResid, pg8::StaticOrder, PG8_ALIGN, PG8_SP2>(glds, g, S, E); SEAM(P + 9); }
        if (IN(P + 10) && l == 1) { PHASE_BEGIN(); float yss = 1.0f;
#ifdef DBG_CHECK
            { const float* da = (const float*)(ws + WS_CTL) + 1024; float r2 = 0.f; if (DBG_CHECK < 4) r2 = da[2 * (DBG_CHECK)] / fmaxf(da[2 * (DBG_CHECK) + 1], 1e-30f); else { for (int c_ = 1; c_ < 4; ++c_) r2 = fmaxf(r2, da[2 * c_] / fmaxf(da[2 * c_ + 1], 1e-30f)); } yss = 1.0f + 10.0f * sqrtf(r2); }
#endif
            ln_phase(F, LG(5), LB(5), F.out, yss); }
#undef ST
#undef CB
#undef LG
#undef LB
    }
#undef IN
#undef SEAM
}

extern "C" void kernel_launch(void* const* d_in, const int* in_sizes, int n_in, void* d_out, int out_size, void* d_ws, size_t ws_size, hipStream_t stream) {
    static int grid = 0;
    if (grid == 0) {
        if (n_in != 21 || (size_t)out_size != O_END || ws_size < WS_END) { fprintf(stderr, "kernel_launch: shape mismatch: n_in %d out %d (want %zu) ws %zu (want >= %zu); nothing launched\n", n_in, out_size, (size_t)O_END, ws_size, (size_t)WS_END); grid = -1; return; }
        int dev = 0, cus = 0, per_cu = 0;
        if (hipGetDevice(&dev) != hipSuccess || hipDeviceGetAttribute(&cus, hipDeviceAttributeMultiprocessorCount, dev) != hipSuccess) { fprintf(stderr, "kernel_launch: device query failed\n"); grid = -1; return; }
        if (hipFuncSetAttribute((const void*)fwd_kernel, hipFuncAttributeMaxDynamicSharedMemorySize, LDS_BYTES) != hipSuccess) { fprintf(stderr, "kernel_launch: hipFuncSetAttribute failed\n"); grid = -1; return; }
        if (hipOccupancyMaxActiveBlocksPerMultiprocessor(&per_cu, (const void*)fwd_kernel, NWAVES * 64, LDS_BYTES) != hipSuccess || per_cu < 1) fprintf(stderr, "kernel_launch: occupancy query reports %d\n", per_cu);
        (void)hipGetLastError();
        grid = cus;
    }
    if (grid < 0) return;
    if (hipMemsetAsync((char*)d_ws + WS_CTL, 0, CTL_ZERO_BYTES, stream) != hipSuccess) { fprintf(stderr, "kernel_launch: memset failed\n"); return; }
    Params a{};
    for (int i = 0; i < 21; ++i) a.in[i] = (const float*)d_in[i];
    a.out = (float*)d_out; a.ws = (unsigned char*)d_ws;
#ifndef MK_CUTS
    a.ph_lo = 0; a.ph_hi = PH_END;
    hipLaunchKernelGGL(fwd_kernel, dim3(grid), dim3(NWAVES * 64), LDS_BYTES, stream, a);
#else
    for (int p = 0; p < PH_END; ++p) { a.ph_lo = p; a.ph_hi = p + 1; hipLaunchKernelGGL(fwd_kernel, dim3(grid), dim3(NWAVES * 64), LDS_BYTES, stream, a); }
#endif
    const hipError_t le = hipPeekAtLastError();
    if (le != hipSuccess) fprintf(stderr, "kernel_launch: launch failed: %s\n", hipGetErrorName(le));
}
```

```cpp
#include <hip/hip_runtime.h>
#include <cstdio>
#include <cstdint>

#define GAS __attribute__((address_space(1)))
#define LAS __attribute__((address_space(3)))
typedef unsigned short bf16;
typedef short bf16x8 __attribute__((ext_vector_type(8)));
typedef short s16x4 __attribute__((ext_vector_type(4)));
typedef float f32x2 __attribute__((ext_vector_type(2)));
typedef float f32x4 __attribute__((ext_vector_type(4)));
typedef float f32x8 __attribute__((ext_vector_type(8)));
typedef float f32x16 __attribute__((ext_vector_type(16)));
typedef unsigned u32x2 __attribute__((ext_vector_type(2)));
typedef unsigned u32x4 __attribute__((ext_vector_type(4)));

constexpr int DM = 2048, NB = 4, SEQ = 8192, DB = 8, DS = 16, PAST = 4096, BBUF = 512, NMEM = 256;
constexpr int MP = NB * SEQ;
constexpr int MS = DB * DS;
constexpr int MR = MP + MS;
constexpr int MPAD = 33024;
constexpr int DFF = 5632, NFF2 = 2 * DFF;
constexpr int NQ = 1536, NKV = 512, NMQ = 512, NIQ = 512, NIK = 64, NIH = 8;
constexpr int PROJ_A = 3656, PROJ_A_PAD = 3840, PROJ_B = 3072;
constexpr float LN_EPS = 1e-5f;
constexpr float ALPHA = 1.41421356237309515f;
constexpr float ATT_SCALE = 0.088388347648318440f;

constexpr size_t O_YP = 0;
constexpr size_t O_YS = O_YP + (size_t)MP * DM;
constexpr size_t O_AKP = O_YS + (size_t)MS * DM;
constexpr size_t O_AVP = O_AKP + (size_t)MP * 512;
constexpr size_t O_AIP = O_AVP + (size_t)MP * 512;
constexpr size_t O_BKP = O_AIP + (size_t)MP * 64;
constexpr size_t O_BVP = O_BKP + (size_t)NB * 512 * 512;
constexpr size_t O_MK = O_BVP + (size_t)NB * 512 * 512;
constexpr size_t O_MV = O_MK + (size_t)2 * NB * NMEM * 512;
constexpr size_t O_AKS = O_MV + (size_t)2 * NB * NMEM * 512;
constexpr size_t O_AVS = O_AKS + (size_t)MS * 512;
constexpr size_t O_AIS = O_AVS + (size_t)MS * 512;
constexpr size_t O_BKS = O_AIS + (size_t)MS * 64;
constexpr size_t O_BVS = O_BKS + (size_t)DB * 512 * 512;
constexpr size_t O_END = O_BVS + (size_t)DB * 512 * 512;

constexpr size_t MiB = 1u << 20;
constexpr size_t WS_CTL = 0, CTL_ZERO_BYTES = 1 * MiB;
constexpr size_t WS_COS128 = 1 * MiB, WS_SIN128 = 3 * MiB;
constexpr size_t WS_COS64 = 5 * MiB, WS_SIN64 = 6 * MiB;
constexpr size_t WS_MEMB = 7 * MiB;
constexpr size_t WS_MKB = 11 * MiB, WS_MVB = 13 * MiB;
constexpr size_t WS_WFI = 16 * MiB;
constexpr size_t WS_WFO = WS_WFI + 4 * 44 * MiB;
constexpr size_t WS_WINA = WS_WFO + 4 * 22 * MiB;
constexpr size_t WS_WINB = WS_WINA + 15 * MiB;
constexpr size_t WS_WO = WS_WINB + 12 * MiB;
constexpr size_t WS_WMEM = WS_WO + 16 * MiB;
constexpr size_t WS_X = WS_WMEM + 8 * MiB;
constexpr size_t WS_R1 = WS_X + 129 * MiB;
constexpr size_t R1_BYTES = 364 * MiB;
constexpr size_t WS_MASK = WS_R1 + R1_BYTES;
constexpr size_t WS_STATS = WS_MASK + 32 * MiB;
constexpr size_t WS_STATP = WS_STATS + 2 * MiB;
constexpr size_t WS_END = WS_STATP + 16 * MiB;
constexpr size_t R1_Q = 0;
constexpr size_t R1_K = R1_Q + (size_t)MPAD * NQ * 2;
constexpr size_t R1_V = R1_K + (size_t)MPAD * NKV * 2;
constexpr size_t R1_QM = R1_V + (size_t)MPAD * NKV * 2;
constexpr size_t R1_QI = R1_QM + (size_t)MPAD * NMQ * 2;
constexpr size_t R1_KI = R1_QI + (size_t)MPAD * NIQ * 2;
constexpr size_t R1_WI = R1_KI + (size_t)MPAD * NIK * 2;
constexpr size_t R1_AO = R1_WI + (size_t)MPAD * NIH * 4;
static_assert(R1_AO + (size_t)MPAD * DM * 2 <= R1_BYTES && (size_t)MPAD * DFF * 2 <= R1_BYTES, "R1 region");
static_assert(WS_X + (size_t)MPAD * DM * 2 <= WS_R1, "X region");
constexpr int CW_BAR = 4096;
constexpr size_t CTL_CSBW = 65536;
constexpr int CSBW_STRIDE = 2 * NFF2;
static_assert(CTL_CSBW + 5 * CSBW_STRIDE * 4 <= CTL_ZERO_BYTES, "csbw inside the memset region");
enum { FM_F2L0 = 0, FM_F1L1 = 1, FM_F2L1 = 2, FM_INA = 3, FM_INB = 4 };

constexpr int RING_BYTES = 131072 + 8192;
constexpr int LDSCTL_OFF = RING_BYTES, MISC_OFF = LDSCTL_OFF + 320;
constexpr int LDS_BYTES = RING_BYTES + 1024;
constexpr int NWAVES = 8;

__host__ __device__ __forceinline__ size_t ki_tiled(size_t row, int d) { return (row >> 5) * 2048 + (size_t)(((d & 31) >> 3) * 512 + (((d >> 5) * 32) + (int)(row & 31)) * 8 + (d & 7)); }
#define RLX_AGENT __ATOMIC_RELAXED, __HIP_MEMORY_SCOPE_AGENT
#define LDS_WAIT() asm volatile("s_waitcnt lgkmcnt(0)" ::: "memory")
#define VM_WAIT() asm volatile("s_waitcnt vmcnt(0)" ::: "memory")
__device__ __forceinline__ unsigned f2bf(float f) { unsigned u = __builtin_bit_cast(unsigned, f); return (u + 0x7fffu + ((u >> 16) & 1u)) >> 16; }
__device__ __forceinline__ unsigned pk2(float lo, float hi) { return f2bf(lo) | (f2bf(hi) << 16); }
__device__ __forceinline__ float bf2f(unsigned short b) { return __builtin_bit_cast(float, (unsigned)b << 16); }
__device__ __forceinline__ unsigned cvt_pk_bf16(float lo, float hi) { unsigned r; asm volatile("v_cvt_pk_bf16_f32 %0, %1, %2" : "=v"(r) : "v"(lo), "v"(hi)); return r; }
__device__ __forceinline__ float wave_sum(float v) {
#pragma unroll
    for (int o = 1; o < 64; o <<= 1) v += __shfl_xor(v, o);
    return v;
}
__device__ __forceinline__ float wave_max(float v) {
#pragma unroll
    for (int o = 1; o < 64; o <<= 1) v = fmaxf(v, __shfl_xor(v, o));
    return v;
}

#define XB_TMO      128
#define XB_XCNT(j)  (256  + 64 * (j))
#define XB_XSUB(j)  (1280 + 64 * (j))
#define XB_XGEN(j)  (2304 + 64 * (j))
#define XB_TOP      3328
#define XB_TOPGEN   3392
#define XCD_BAR_WORDS 3456
#define XB_SPIN_CAP (1u << 18)

__device__ __forceinline__ unsigned xb_ld(unsigned* p)              { return __hip_atomic_load(p, __ATOMIC_RELAXED, __HIP_MEMORY_SCOPE_AGENT); }
__device__ __forceinline__ unsigned xb_add(unsigned* p, unsigned v) { return __hip_atomic_fetch_add(p, v, __ATOMIC_RELAXED, __HIP_MEMORY_SCOPE_AGENT); }
__device__ __forceinline__ unsigned xb_xcc_id() { return (unsigned)__builtin_amdgcn_s_getreg((3 << 11) | 20) & 0xFu; }
#define XB_SPIN(cond, bar) do { unsigned _sp = 0; while (cond) { __builtin_amdgcn_s_sleep(1); \
    if ((++_sp & 255u) == 0u) { if (xb_ld(&(bar)[XB_TMO])) break; if (_sp > XB_SPIN_CAP) { atomicAdd(&(bar)[XB_TMO], 1u); break; } } } } while (0)

struct XcdBarrier {
    unsigned* bar; unsigned x;
    volatile LAS unsigned* st;
};

__device__ __forceinline__ XcdBarrier xcd_barrier_post(unsigned* bar, volatile LAS unsigned* st) {
    XcdBarrier b; b.bar = bar; b.x = xb_xcc_id(); b.st = st;
    if (threadIdx.x == 0) (void)xb_add(&bar[XB_XCNT(b.x)], 1u);
    return b;
}
__device__ __forceinline__ void xcd_barrier_complete(unsigned* bar, unsigned x, unsigned& nloc, unsigned& nx) {
    const unsigned G = gridDim.x * gridDim.y * gridDim.z;
    unsigned sum, cnt, mine, sp = 0u;
    for (;;) {
        sum = 0u; cnt = 0u; mine = 0u;
#pragma unroll
        for (unsigned j = 0; j < 16; ++j) { const unsigned c = xb_ld(&bar[XB_XCNT(j)]); sum += c; cnt += (c > 0u) ? 1u : 0u; mine = (j == x) ? c : mine; }
        if (sum == G) break;
        __builtin_amdgcn_s_sleep(1);
        if ((++sp & 255u) == 0u) { if (xb_ld(&bar[XB_TMO])) break; if (sp > XB_SPIN_CAP) { atomicAdd(&bar[XB_TMO], 1u); break; } }
    }
    nloc = mine > 0u ? mine : 1u; nx = cnt > 0u ? cnt : 1u;
}

__device__ __forceinline__ void xcd_barrier(const XcdBarrier& b) {
    asm volatile("s_waitcnt vmcnt(0)" ::: "memory");
    __syncthreads();
    if (threadIdx.x == 0) {
        unsigned* bar = b.bar;
        __builtin_amdgcn_s_waitcnt(0);
        unsigned nloc = b.st[0], nx = b.st[1];
        if (nloc == 0u) { xcd_barrier_complete(bar, b.x, nloc, nx); b.st[0] = nloc; b.st[1] = nx; }
        const unsigned old = xb_add(&bar[XB_XSUB(b.x)], 1u);
        const unsigned gen = old / nloc;
        if (old + 1u == (gen + 1u) * nloc) {
            __builtin_amdgcn_fence(__ATOMIC_RELEASE, "agent");
            asm volatile("s_waitcnt vmcnt(0)" ::: "memory");
            const unsigned og = xb_add(&bar[XB_TOP], 1u);
            const unsigned tg = og / nx;
            if (og + 1u == (tg + 1u) * nx) xb_add(&bar[XB_TOPGEN], 1u);
            else XB_SPIN(xb_ld(&bar[XB_TOPGEN]) == tg, bar);
            __builtin_amdgcn_fence(__ATOMIC_ACQUIRE, "agent");
            xb_add(&bar[XB_XGEN(b.x)], 1u);
            asm volatile("s_waitcnt vmcnt(0)" ::: "memory");
        } else {
            XB_SPIN(xb_ld(&bar[XB_XGEN(b.x)]) == gen, bar);
            __builtin_amdgcn_fence(__ATOMIC_ACQUIRE, "agent");
            asm volatile("s_waitcnt vmcnt(0)" ::: "memory");
        }
    }
    __syncthreads();
}
namespace pg8 {
#define PG8_LAS __attribute__((address_space(3)))
typedef unsigned short bf16_t;
typedef short bf16x8 __attribute__((ext_vector_type(8)));
typedef float f32x4 __attribute__((ext_vector_type(4)));
typedef unsigned u32x4 __attribute__((ext_vector_type(4)));
constexpr int BM = 256, BK = 64, HALF = 128, HTB = HALF * BK * 2  , STAGE_BYTES = 8 * HTB, NXCD = 8, WGM = 8;

__host__ __device__ __forceinline__ int lds_byte(int r, int c) { const int st = (r >> 4) * 2 + (c >> 5), rr = r & 15, cc = c & 31, ob = rr * 64 + cc * 2; return st * 1024 + (ob ^ (((ob >> 9) & 1) << 5)); }
__host__ __device__ __forceinline__ void stage_rc(int b, int& R, int& C) { const int st = b / 1024, sb = b % 1024, swz = sb ^ (((sb >> 9) & 1) << 5); R = (st >> 1) * 16 + swz / 64; C = (st & 1) * 32 + (swz % 64) / 2; }
__host__ __device__ __forceinline__ int perm32(int rho) { const int n = rho >> 4, i = rho & 15; return 8 * (i >> 2) + 4 * n + (i & 3); }

struct Unit { int pm, pn; };
struct Gemm { const bf16_t* A; const bf16_t* Bt; int M, N, K; };

struct StaticOrder {
    int nM, nN, nwg, G, c;
    __host__ __device__ void init(int M, int N, int G_, int c_) { nM = M / BM; nN = N / BM; nwg = nM * nN; G = G_; c = c_; }
    __host__ __device__ bool next(int i, Unit& u) const {
        const long L = (long)i * G + c; if (L >= nwg) return false;
        int wgid = (int)L; { const int q = nwg / NXCD, r = nwg % NXCD, xcd = wgid % NXCD, off = wgid / NXCD; wgid = (xcd < r ? xcd * (q + 1) : r * (q + 1) + (xcd - r) * q) + off; }
        const int nig = WGM * nN, gid = wgid / nig, fm = gid * WGM, gsz = (nM - fm) < WGM ? (nM - fm) : WGM;
        u.pm = fm + ((wgid % nig) % gsz); u.pn = (wgid % nig) / gsz; return true;
    }
    __device__ __forceinline__ void a_ready(const Unit&) const {}
    __device__ __forceinline__ void done(const Unit&) const {}
};
__device__ __forceinline__ unsigned cvt_pk_bf16(float lo, float hi) { unsigned r; asm volatile("v_cvt_pk_bf16_f32 %0, %1, %2" : "=v"(r) : "v"(lo), "v"(hi)); return r; }
typedef float f32x2 __attribute__((ext_vector_type(2)));

__device__ __forceinline__ u32x4 pack8(const f32x4 a, const f32x4 b) { u32x4 w; w.x = cvt_pk_bf16(a[0], a[1]); w.y = cvt_pk_bf16(a[2], a[3]); w.z = cvt_pk_bf16(b[0], b[1]); w.w = cvt_pk_bf16(b[2], b[3]); return w; }
__device__ __forceinline__ void unpack8(const u32x4 w, f32x4& a, f32x4& b) {
    a[0] = __builtin_bit_cast(float, w.x << 16); a[1] = __builtin_bit_cast(float, w.x & 0xffff0000u); a[2] = __builtin_bit_cast(float, w.y << 16); a[3] = __builtin_bit_cast(float, w.y & 0xffff0000u);
    b[0] = __builtin_bit_cast(float, w.z << 16); b[1] = __builtin_bit_cast(float, w.z & 0xffff0000u); b[2] = __builtin_bit_cast(float, w.w << 16); b[3] = __builtin_bit_cast(float, w.w & 0xffff0000u); }
__device__ __forceinline__ f32x4 silu_mul(const f32x4 g, const f32x4 u) {
    f32x4 r;
#pragma unroll
    for (int i = 0; i < 4; ++i) { const float e = __builtin_amdgcn_exp2f(g[i] * -1.4426950408889634f); r[i] = g[i] * __builtin_amdgcn_rcpf(1.0f + e) * u[i]; }
    return r; }

__device__ __forceinline__ void row_mu_rstd(const float* st, int row, float& mu, float& rstd) { const f32x2 s = *(const GAS f32x2*)(st + 2 * (size_t)row); mu = s[0] * (1.0f / DM); const float var = s[1] * (1.0f / DM) - mu * mu; rstd = __builtin_amdgcn_rsqf(fmaxf(var, 0.f) + LN_EPS); }
__device__ __forceinline__ void ln_fix8(f32x4& a0, f32x4& a1, const float* cb, int n, float mu, float rstd) {
    const f32x4 p0 = *(const f32x4*)(cb + 2 * n), p1 = *(const f32x4*)(cb + 2 * n + 4), p2 = *(const f32x4*)(cb + 2 * n + 8), p3 = *(const f32x4*)(cb + 2 * n + 12);
    a0[0] = rstd * (a0[0] - mu * p0[0]) + p0[1]; a0[1] = rstd * (a0[1] - mu * p0[2]) + p0[3]; a0[2] = rstd * (a0[2] - mu * p1[0]) + p1[1]; a0[3] = rstd * (a0[3] - mu * p1[2]) + p1[3];
    a1[0] = rstd * (a1[0] - mu * p2[0]) + p2[1]; a1[1] = rstd * (a1[1] - mu * p2[2]) + p2[3]; a1[2] = rstd * (a1[2] - mu * p3[0]) + p3[1]; a1[3] = rstd * (a1[3] - mu * p3[2]) + p3[3]; }
__device__ __forceinline__ float sum_fq(float x) {
    { auto r = __builtin_amdgcn_permlane16_swap(__float_as_uint(x), __float_as_uint(x), false, false); x = __uint_as_float(r[0]) + __uint_as_float(r[1]); }
    { auto r = __builtin_amdgcn_permlane32_swap(__float_as_uint(x), __float_as_uint(x), false, false); x = __uint_as_float(r[0]) + __uint_as_float(r[1]); }
    return x; }
struct ColFix { f32x4 p0, p1, p2, p3; };
__device__ __forceinline__ ColFix colfix_load(const float* cb, int n) { ColFix c; c.p0 = *(const GAS f32x4*)(cb + 2 * n); c.p1 = *(const GAS f32x4*)(cb + 2 * n + 4); c.p2 = *(const GAS f32x4*)(cb + 2 * n + 8); c.p3 = *(const GAS f32x4*)(cb + 2 * n + 12); return c; }
__device__ __forceinline__ void colfix_apply(f32x4& a0, f32x4& a1, const ColFix& c, float mu, float rstd) {
    a0[0] = rstd * (a0[0] - mu * c.p0[0]) + c.p0[1]; a0[1] = rstd * (a0[1] - mu * c.p0[2]) + c.p0[3]; a0[2] = rstd * (a0[2] - mu * c.p1[0]) + c.p1[1]; a0[3] = rstd * (a0[3] - mu * c.p1[2]) + c.p1[3];
    a1[0] = rstd * (a1[0] - mu * c.p2[0]) + c.p2[1]; a1[1] = rstd * (a1[1] - mu * c.p2[2]) + c.p2[3]; a1[2] = rstd * (a1[2] - mu * c.p3[0]) + c.p3[1]; a1[3] = rstd * (a1[3] - mu * c.p3[2]) + c.p3[3]; }
__device__ __forceinline__ void stats_to_mu_rstd(const f32x2 s, float& mu, float& rstd) { mu = s[0] * (1.0f / DM); const float var = s[1] * (1.0f / DM) - mu * mu; rstd = __builtin_amdgcn_rsqf(fmaxf(var, 0.f) + LN_EPS); }
struct EpiSwiglu {
    static constexpr bool PERM = true, AFTER_DRAIN = false;
    bf16_t* H; const float* st; const float* cb; int ln;
    __device__ __forceinline__ void operator()(const f32x4 (&acc)[2][2][4][2], const Unit& u, int wr, int wc, int fr, int fq) const {
        asm volatile("" : "+v"(fr), "+v"(fq));
        const int row0 = u.pm * BM + wr * 64 + fr, col0 = u.pn * HALF + wc * 32 + 8 * fq, n0 = u.pn * BM + wc * 32 + 8 * fq;
        f32x2 sr[2][4]; ColFix cg, cu;
        if (ln) { cg = colfix_load(cb, n0); cu = colfix_load(cb, n0 + HALF);
#pragma unroll
            for (int ai = 0; ai < 2; ++ai)
#pragma unroll
                for (int m = 0; m < 4; ++m) sr[ai][m] = *(const GAS f32x2*)(st + 2 * (size_t)(row0 + ai * HALF + m * 16)); }
#pragma unroll
        for (int ai = 0; ai < 2; ++ai)
#pragma unroll
            for (int m = 0; m < 4; ++m) { const int row = row0 + ai * HALF + m * 16;
                bf16_t* p = H + (size_t)row * DFF + col0;
                f32x4 g0 = acc[ai][0][m][0], g1 = acc[ai][0][m][1], u0 = acc[ai][1][m][0], u1 = acc[ai][1][m][1];
                if (ln) { float mu, rstd; stats_to_mu_rstd(sr[ai][m], mu, rstd); colfix_apply(g0, g1, cg, mu, rstd); colfix_apply(u0, u1, cu, mu, rstd); }
                const f32x4 h0 = silu_mul(g0, u0), h1 = silu_mul(g1, u1);
                *(u32x4*)p = pack8(h0, h1); }
    }
};
struct EpiResid {
    static constexpr bool PERM = true, AFTER_DRAIN = false;
    bf16_t* X; float cs; float al; const float* sto; const float* g; const float* b; float* stn; int ln;
    __device__ __forceinline__ void operator()(const f32x4 (&acc)[2][2][4][2], const Unit& u, int wr, int wc, int fr, int fq) const {
        asm volatile("" : "+v"(fr), "+v"(fq));
        const int row0 = u.pm * BM + wr * 64 + fr, col0 = u.pn * BM + wc * 32 + 8 * fq;
        f32x4 gv[2][2], bv[2][2]; f32x2 sr[2][4];
        if (ln) {
#pragma unroll
            for (int bj = 0; bj < 2; ++bj) { gv[bj][0] = *(const GAS f32x4*)(g + col0 + bj * HALF); gv[bj][1] = *(const GAS f32x4*)(g + col0 + bj * HALF + 4); bv[bj][0] = *(const GAS f32x4*)(b + col0 + bj * HALF); bv[bj][1] = *(const GAS f32x4*)(b + col0 + bj * HALF + 4); }
#pragma unroll
            for (int ai = 0; ai < 2; ++ai)
#pragma unroll
                for (int m = 0; m < 4; ++m) sr[ai][m] = *(const GAS f32x2*)(sto + 2 * (size_t)(row0 + ai * HALF + m * 16)); }
#pragma unroll
        for (int am = 0; am < 8; am += 2) {
            u32x4 xin[2][2];
#pragma unroll
            for (int mm = 0; mm < 2; ++mm)
#pragma unroll
                for (int bj = 0; bj < 2; ++bj) xin[mm][bj] = *(const u32x4*)(X + (size_t)(row0 + ((am + mm) >> 2) * HALF + ((am + mm) & 3) * 16) * DM + col0 + bj * HALF);
#pragma unroll
            for (int mm = 0; mm < 2; ++mm) { const int ai = (am + mm) >> 2, m = (am + mm) & 3; const int row = row0 + ai * HALF + m * 16;
                bf16_t* p = X + (size_t)row * DM + col0; float mu = 0.f, rstd = 1.f; if (ln) stats_to_mu_rstd(sr[ai][m], mu, rstd);
                float s1 = 0.f, s2 = 0.f;
#pragma unroll
                for (int bj = 0; bj < 2; ++bj) { f32x4 x0, x1; unpack8(xin[mm][bj], x0, x1);
                    if (ln) { x0 = (x0 - mu) * rstd * gv[bj][0] + bv[bj][0]; x1 = (x1 - mu) * rstd * gv[bj][1] + bv[bj][1]; }
                    const f32x4 v0 = x0 * al + acc[ai][bj][m][0] * cs, v1 = x1 * al + acc[ai][bj][m][1] * cs;
                    s1 += (v0[0] + v0[1]) + (v0[2] + v0[3]) + (v1[0] + v1[1]) + (v1[2] + v1[3]);
                    s2 += (v0[0] * v0[0] + v0[1] * v0[1]) + (v0[2] * v0[2] + v0[3] * v0[3]) + (v1[0] * v1[0] + v1[1] * v1[1]) + (v1[2] * v1[2] + v1[3] * v1[3]);
                    *(u32x4*)(p + bj * HALF) = pack8(v0, v1); }
                s1 += __shfl_xor(s1, 16); s1 += __shfl_xor(s1, 32); s2 += __shfl_xor(s2, 16); s2 += __shfl_xor(s2, 32);
                if (fq == 0) *(GAS f32x2*)(stn + ((size_t)row * 32 + u.pn * 4 + wc) * 2) = (f32x2){s1, s2}; }
        }
    }
};
struct EpiMem {
    static constexpr bool PERM = true, AFTER_DRAIN = false;
    float* omk; float* omv; bf16_t* mkb; bf16_t* mvb;
    __device__ __forceinline__ void operator()(const f32x4 (&acc)[2][2][4][2], const Unit& u, int wr, int wc, int fr, int fq) const {
        const int row0 = u.pm * BM + wr * 64 + fr; const int l = u.pn >> 2, isv = (u.pn >> 1) & 1, cbase = (u.pn & 1) * BM + wc * 32 + 8 * fq;
        float* of = isv ? omv : omk; bf16_t* ob = isv ? mvb : mkb;
#pragma unroll
        for (int ai = 0; ai < 2; ++ai)
#pragma unroll
            for (int m = 0; m < 4; ++m) { const size_t off = ((size_t)l * 1024 + row0 + ai * HALF + m * 16) * 512 + cbase;
#pragma unroll
                for (int bj = 0; bj < 2; ++bj) { *(f32x4*)(of + off + bj * HALF) = acc[ai][bj][m][0]; *(f32x4*)(of + off + bj * HALF + 4) = acc[ai][bj][m][1];
                    *(u32x4*)(ob + off + bj * HALF) = pack8(acc[ai][bj][m][0], acc[ai][bj][m][1]); } }
    }
};
__device__ __forceinline__ int row_pos(int row) { return row < MP ? (row & (SEQ - 1)) : PAST + ((row - MP) & (DS - 1)); }
__device__ __forceinline__ void rope8(const f32x4 a0, const f32x4 a1, const f32x4 b0, const f32x4 b1, const float* ct, const float* st, f32x4& o10, f32x4& o11, f32x4& o20, f32x4& o21) {
    const f32x4 c0 = *(const f32x4*)ct, c1 = *(const f32x4*)(ct + 4), s0 = *(const f32x4*)st, s1 = *(const f32x4*)(st + 4);
    o10 = a0 * c0 - b0 * s0; o11 = a1 * c1 - b1 * s1; o20 = b0 * c0 + a0 * s0; o21 = b1 * c1 + a1 * s1; }
struct EpiInA {
    static constexpr bool PERM = true, AFTER_DRAIN = false;
    unsigned char* ws; float* out; const float* st; const float* cb;
    __device__ __forceinline__ void operator()(const f32x4 (&acc)[2][2][4][2], const Unit& u, int wr, int wc, int fr, int fq) const {
        bf16_t* q = (bf16_t*)(ws + WS_R1 + R1_Q); bf16_t* k = (bf16_t*)(ws + WS_R1 + R1_K); bf16_t* v = (bf16_t*)(ws + WS_R1 + R1_V); bf16_t* qm = (bf16_t*)(ws + WS_R1 + R1_QM);
        bf16_t* qi = (bf16_t*)(ws + WS_R1 + R1_QI); bf16_t* ki = (bf16_t*)(ws + WS_R1 + R1_KI); float* wi = (float*)(ws + WS_R1 + R1_WI);
        const float* c128 = (const float*)(ws + WS_COS128); const float* s128 = (const float*)(ws + WS_SIN128); const float* c64 = (const float*)(ws + WS_COS64); const float* s64 = (const float*)(ws + WS_SIN64);
        asm volatile("" : "+v"(fr), "+v"(fq));
        const int row0 = u.pm * BM + wr * 64 + fr, lc0 = wc * 32 + 8 * fq, pn = u.pn;
        const ColFix ca = colfix_load(cb, pn * BM + lc0), cbf = colfix_load(cb, pn * BM + HALF + lc0);
#pragma unroll
        for (int ai = 0; ai < 2; ++ai) { f32x2 sr[1][4];
#pragma unroll
            for (int m = 0; m < 4; ++m) {
                if ((m & 1) == 0) { sr[0][m] = *(const GAS f32x2*)(st + 2 * (size_t)(row0 + ai * HALF + m * 16)); sr[0][m + 1] = *(const GAS f32x2*)(st + 2 * (size_t)(row0 + ai * HALF + (m + 1) * 16)); }
                const int row = row0 + ai * HALF + m * 16; if (row >= MR) continue;
                const int pos = row_pos(row);
                f32x4 a0 = acc[ai][0][m][0], a1 = acc[ai][0][m][1], b0 = acc[ai][1][m][0], b1 = acc[ai][1][m][1];
                { float mu, rstd; stats_to_mu_rstd(sr[0][m], mu, rstd); colfix_apply(a0, a1, ca, mu, rstd); colfix_apply(b0, b1, cbf, mu, rstd); }
                if (pn < 8) {
                    const int d0 = lc0 & 63; f32x4 o10, o11, o20, o21;
                    rope8(a0, a1, b0, b1, c128 + (size_t)pos * 64 + d0, s128 + (size_t)pos * 64 + d0, o10, o11, o20, o21);
                    if (pn < 6) { bf16_t* p = q + (size_t)row * NQ + (2 * pn + (lc0 >> 6)) * 128 + d0; *(u32x4*)p = pack8(o10, o11); *(u32x4*)(p + 64) = pack8(o20, o21); }
                    else { const int c = (2 * (pn - 6) + (lc0 >> 6)) * 128 + d0; bf16_t* p = k + (size_t)row * NKV + c; *(u32x4*)p = pack8(o10, o11); *(u32x4*)(p + 64) = pack8(o20, o21);
                        float* o = out + (row < MP ? O_AKP + (size_t)row * 512 : O_AKS + (size_t)(row - MP) * 512) + c;
                        *(f32x4*)o = o10; *(f32x4*)(o + 4) = o11; *(f32x4*)(o + 64) = o20; *(f32x4*)(o + 68) = o21; }
                } else if (pn < 10) {
                    const int c = (pn - 8) * BM + lc0; bf16_t* p = v + (size_t)row * NKV + c; *(u32x4*)p = pack8(a0, a1); *(u32x4*)(p + HALF) = pack8(b0, b1);
                    float* o = out + (row < MP ? O_AVP + (size_t)row * 512 : O_AVS + (size_t)(row - MP) * 512) + c;
                    *(f32x4*)o = a0; *(f32x4*)(o + 4) = a1; *(f32x4*)(o + HALF) = b0; *(f32x4*)(o + HALF + 4) = b1;
                } else if (pn < 12) {
                    bf16_t* p = qm + (size_t)row * NMQ + (pn - 10) * BM + lc0; *(u32x4*)p = pack8(a0, a1); *(u32x4*)(p + HALF) = pack8(b0, b1);
                } else if (pn < 14) {
                    const int d0 = 8 * fq; f32x4 o10, o11, o20, o21;
                    rope8(a0, a1, b0, b1, c64 + (size_t)pos * 32 + d0, s64 + (size_t)pos * 32 + d0, o10, o11, o20, o21);
                    bf16_t* p = qi + (size_t)row * NIQ + (4 * (pn - 12) + wc) * 64 + d0; *(u32x4*)p = pack8(o10, o11); *(u32x4*)(p + 32) = pack8(o20, o21);
                } else {
                    if (wc == 0) { const int d0 = 8 * fq; f32x4 o10, o11, o20, o21;
                        rope8(a0, a1, b0, b1, c64 + (size_t)pos * 32 + d0, s64 + (size_t)pos * 32 + d0, o10, o11, o20, o21);
                        bf16_t* p = ki + (size_t)(row >> 5) * 2048 + fq * 512 + (row & 31) * 8; *(u32x4*)p = pack8(o10, o11); *(u32x4*)(p + 256) = pack8(o20, o21);
                        float* o = out + (row < MP ? O_AIP + (size_t)row * 64 : O_AIS + (size_t)(row - MP) * 64) + d0;
                        *(f32x4*)o = o10; *(f32x4*)(o + 4) = o11; *(f32x4*)(o + 32) = o20; *(f32x4*)(o + 36) = o21;
                    } else if (wc == 1 && fq == 0) { float* o = wi + (size_t)row * NIH; *(f32x4*)o = a0; *(f32x4*)(o + 4) = a1; }
                }
                asm volatile("" ::: "memory");
            } }
    }
};
struct EpiInB {
    static constexpr bool PERM = true, AFTER_DRAIN = false;
    unsigned char* ws; float* out; const float* st; const float* cb;
    __device__ __forceinline__ void operator()(const f32x4 (&acc)[2][2][4][2], const Unit& u, int wr, int wc, int fr, int fq) const {
        bf16_t* q = (bf16_t*)(ws + WS_R1 + R1_Q); bf16_t* k = (bf16_t*)(ws + WS_R1 + R1_K); bf16_t* v = (bf16_t*)(ws + WS_R1 + R1_V); bf16_t* qm = (bf16_t*)(ws + WS_R1 + R1_QM);
        asm volatile("" : "+v"(fr), "+v"(fq));
        const int row0 = u.pm * BM + wr * 64 + fr, lc0 = wc * 32 + 8 * fq, pn = u.pn;
        const ColFix ca = colfix_load(cb, pn * BM + lc0), cbf = colfix_load(cb, pn * BM + HALF + lc0);
#pragma unroll
        for (int ai = 0; ai < 2; ++ai) { f32x2 sr[1][4];
#pragma unroll
            for (int m = 0; m < 4; ++m) sr[0][m] = *(const GAS f32x2*)(st + 2 * (size_t)(row0 + ai * HALF + m * 16));
#pragma unroll
            for (int m = 0; m < 4; ++m) {
                const int row = row0 + ai * HALF + m * 16; if (row >= MR) continue;
                f32x4 a0 = acc[ai][0][m][0], a1 = acc[ai][0][m][1], b0 = acc[ai][1][m][0], b1 = acc[ai][1][m][1];
                { float mu, rstd; stats_to_mu_rstd(sr[0][m], mu, rstd); colfix_apply(a0, a1, ca, mu, rstd); colfix_apply(b0, b1, cbf, mu, rstd); }
                if (pn < 6) { bf16_t* p = q + (size_t)row * NQ + pn * BM + lc0; *(u32x4*)p = pack8(a0, a1); *(u32x4*)(p + HALF) = pack8(b0, b1); }
                else if (pn < 10) {
                    const int isv = pn >= 8, c = ((pn - 6) & 1) * BM + lc0; bf16_t* p = (isv ? v : k) + (size_t)row * NKV + c; *(u32x4*)p = pack8(a0, a1); *(u32x4*)(p + HALF) = pack8(b0, b1);
                    float* o = nullptr;
                    if (row < MP) { const int t = row & (SEQ - 1), b = row >> 13; if (t >= SEQ - 512) o = out + (isv ? O_BVP : O_BKP) + ((size_t)b * 512 + (t - (SEQ - 512))) * 512 + c; }
                    else { const int sb = (row - MP) >> 4, st = (row - MP) & 15; o = out + (isv ? O_BVS : O_BKS) + ((size_t)sb * 512 + (BBUF - DS) + st) * 512 + c; }
                    if (o) { *(f32x4*)o = a0; *(f32x4*)(o + 4) = a1; *(f32x4*)(o + HALF) = b0; *(f32x4*)(o + HALF + 4) = b1; }
                } else { bf16_t* p = qm + (size_t)row * NMQ + (pn - 10) * BM + lc0; *(u32x4*)p = pack8(a0, a1); *(u32x4*)(p + HALF) = pack8(b0, b1); }
            } }
    }
};
template <class Epi, class Sched, bool ALIGN_EPI = false, bool SP2 = false>
__device__ __forceinline__ void gemm_phase(PG8_LAS unsigned char* lds, const Gemm g, const Sched& S, const Epi& E) {
    int tid = threadIdx.x; asm volatile("" : "+v"(tid));
    const int wid = __builtin_amdgcn_readfirstlane(tid >> 6), lane = tid & 63, wr = wid >> 2, wc = wid & 3, fr = lane & 15, fq = lane >> 4;
    const int K = g.K, nt = K / BK;
    unsigned voffA[2], voffB[2];
#pragma unroll
    for (int i = 0; i < 2; ++i) { int R, C; stage_rc(tid * 16 + i * 8192, R, C); const int Rb = Epi::PERM ? ((R & ~31) + perm32(R & 31)) : R;
        voffA[i] = (unsigned)(R * K + C) * 2u; voffB[i] = (unsigned)(Rb * K + C) * 2u; }
    const size_t kstep = (size_t)(BK * 2);
    const size_t hstep = (size_t)HALF * K * 2;
    const size_t tstep = 2 * hstep;
    const unsigned ldsw = (unsigned)wid * 1024u;
    const int aoff = lds_byte(wr * 64 + fr, fq * 8), boff = lds_byte(wc * 32 + fr, fq * 8);
#define PG8_SA(b, h) (((b) * 2 + (h)) * HTB)
#define PG8_SB(b, h) ((4 + (b) * 2 + (h)) * HTB)
#define PG8_STAGE(bufoff, gbase, voff) do { _Pragma("unroll") for (int _i = 0; _i < 2; ++_i) \
        __builtin_amdgcn_global_load_lds((const unsigned*)((const char*)(gbase) + (voff)[_i]), (PG8_LAS unsigned*)(lds + (bufoff) + ldsw + _i * 8192), 16, 0, 0); } while (0)
#define PG8_LDA(dst, b, h) do { _Pragma("unroll") for (int m = 0; m < 4; ++m) _Pragma("unroll") for (int k = 0; k < 2; ++k) dst[m][k] = *(const PG8_LAS bf16x8*)(lds + PG8_SA(b, h) + aoff + m * 2048 + k * 1024); } while (0)
#define PG8_LDB(dst, b, h) do { _Pragma("unroll") for (int n = 0; n < 2; ++n) _Pragma("unroll") for (int k = 0; k < 2; ++k) dst[n][k] = *(const PG8_LAS bf16x8*)(lds + PG8_SB(b, h) + boff + n * 2048 + k * 1024); } while (0)
#define PG8_MMA(ai, bj, At, Bt) do { __builtin_amdgcn_s_setprio(1); _Pragma("unroll") for (int m = 0; m < 4; ++m) _Pragma("unroll") for (int n = 0; n < 2; ++n) _Pragma("unroll") for (int k = 0; k < 2; ++k) \
        acc[ai][bj][m][n] = __builtin_amdgcn_mfma_f32_16x16x32_bf16(Bt[n][k], At[m][k], acc[ai][bj][m][n], 0, 0, 0); __builtin_amdgcn_s_setprio(0); } while (0)
#define PG8_WAIT_V(n) asm volatile("s_waitcnt vmcnt(" #n ")" ::: "memory")
#define PG8_WAIT_L(n) asm volatile("s_waitcnt lgkmcnt(" #n ")" ::: "memory")
#define PG8_BAR __builtin_amdgcn_s_barrier()
#define PG8_SCHED __builtin_amdgcn_sched_barrier(0)
    Unit cur, nxt; int ui = 0;
    if (!S.next(0, cur)) return;
    f32x4 acc[2][2][4][2];
#pragma unroll
    for (int a = 0; a < 2; ++a)
#pragma unroll
        for (int b = 0; b < 2; ++b)
#pragma unroll
            for (int m = 0; m < 4; ++m)
#pragma unroll
                for (int n = 0; n < 2; ++n) acc[a][b][m][n] = (f32x4){0.f, 0.f, 0.f, 0.f};
    bf16x8 At[4][2], B0[2][2], B1[2][2];
    const char* cA = (const char*)g.A + (size_t)cur.pm * tstep; const char* cB = (const char*)g.Bt + (size_t)cur.pn * tstep;
    S.a_ready(cur);
    if constexpr (SP2) {
        PG8_STAGE(PG8_SB(0, 0), cB, voffB); PG8_STAGE(PG8_SB(0, 1), cB + hstep, voffB); PG8_STAGE(PG8_SA(0, 0), cA, voffA); PG8_STAGE(PG8_SA(0, 1), cA + hstep, voffA);
        if (wr == 1) PG8_BAR;
        PG8_WAIT_V(2); PG8_BAR;
        PG8_STAGE(PG8_SB(1, 0), cB + kstep, voffB); PG8_STAGE(PG8_SA(1, 0), cA + kstep, voffA); PG8_STAGE(PG8_SB(1, 1), cB + hstep + kstep, voffB);
        PG8_WAIT_V(6); PG8_BAR;
    } else {
        PG8_STAGE(PG8_SB(0, 0), cB, voffB); PG8_STAGE(PG8_SA(0, 0), cA, voffA); PG8_STAGE(PG8_SB(0, 1), cB + hstep, voffB); PG8_STAGE(PG8_SA(0, 1), cA + hstep, voffA);
        if (wr == 1) PG8_BAR;
        PG8_WAIT_V(4); PG8_BAR;
        PG8_STAGE(PG8_SB(1, 0), cB + kstep, voffB); PG8_STAGE(PG8_SA(1, 0), cA + kstep, voffA); PG8_STAGE(PG8_SB(1, 1), cB + hstep + kstep, voffB);
        PG8_WAIT_V(6); PG8_BAR;
    }
    for (;;) {
        const bool has_next = S.next(ui + 1, nxt);
        const char* nA = has_next ? (const char*)g.A + (size_t)nxt.pm * tstep : cA; const char* nB = has_next ? (const char*)g.Bt + (size_t)nxt.pn * tstep : cB;
        for (int t = 0; t < nt; t += 2) {
            const bool last = (t == nt - 2);
            const char* a1 = cA + (size_t)(t + 1) * kstep;
            const char* a2 = last ? nA : cA + (size_t)(t + 2) * kstep; const char* b2 = last ? nB : cB + (size_t)(t + 2) * kstep;
            const char* a3 = a2 + kstep; const char* b3 = b2 + kstep;
            if (last && has_next) S.a_ready(nxt);
            if constexpr (SP2) {
            PG8_LDB(B0, 0, 0); PG8_LDB(B1, 0, 1); PG8_SCHED; PG8_LDA(At, 0, 0); PG8_STAGE(PG8_SA(1, 1), a1 + hstep, voffA);
            PG8_WAIT_V(8); PG8_WAIT_L(0); PG8_BAR; PG8_MMA(0, 0, At, B0); PG8_MMA(0, 1, At, B1); PG8_BAR; PG8_SCHED;
            PG8_LDA(At, 0, 1); PG8_STAGE(PG8_SB(0, 0), b2, voffB); PG8_STAGE(PG8_SB(0, 1), b2 + hstep, voffB); PG8_STAGE(PG8_SA(0, 0), a2, voffA);
            PG8_WAIT_V(8); PG8_WAIT_L(0); PG8_BAR; PG8_MMA(1, 0, At, B0); PG8_MMA(1, 1, At, B1); PG8_BAR; PG8_SCHED;
            PG8_LDB(B0, 1, 0); PG8_LDB(B1, 1, 1); PG8_SCHED; PG8_LDA(At, 1, 0); PG8_STAGE(PG8_SA(0, 1), a2 + hstep, voffA);
            PG8_WAIT_V(8); PG8_WAIT_L(0); PG8_BAR; PG8_MMA(0, 0, At, B0); PG8_MMA(0, 1, At, B1); PG8_BAR; PG8_SCHED;
            PG8_LDA(At, 1, 1); PG8_STAGE(PG8_SB(1, 0), b3, voffB); PG8_STAGE(PG8_SB(1, 1), b3 + hstep, voffB); PG8_STAGE(PG8_SA(1, 0), a3, voffA);
            PG8_WAIT_V(8); PG8_WAIT_L(0); PG8_BAR; PG8_MMA(1, 0, At, B0); PG8_MMA(1, 1, At, B1); PG8_BAR; PG8_SCHED;
            } else {
            PG8_LDB(B0, 0, 0); PG8_SCHED; PG8_LDA(At, 0, 0); PG8_STAGE(PG8_SA(1, 1), a1 + hstep, voffA);
            PG8_WAIT_L(8); PG8_BAR; PG8_WAIT_L(0); PG8_MMA(0, 0, At, B0); PG8_BAR; PG8_SCHED;
            PG8_LDB(B1, 0, 1); PG8_STAGE(PG8_SB(0, 0), b2, voffB);
            PG8_BAR; PG8_WAIT_L(0); PG8_MMA(0, 1, At, B1); PG8_BAR;
            PG8_LDA(At, 0, 1); PG8_STAGE(PG8_SA(0, 0), a2, voffA);
            PG8_BAR; PG8_WAIT_L(0); PG8_MMA(1, 0, At, B0); PG8_BAR; PG8_SCHED;
            PG8_STAGE(PG8_SB(0, 1), b2 + hstep, voffB);
            PG8_WAIT_V(6); PG8_BAR; PG8_MMA(1, 1, At, B1); PG8_BAR;
            PG8_LDB(B0, 1, 0); PG8_SCHED; PG8_LDA(At, 1, 0); PG8_STAGE(PG8_SA(0, 1), a2 + hstep, voffA);
            PG8_WAIT_L(8); PG8_BAR; PG8_WAIT_L(0); PG8_MMA(0, 0, At, B0); PG8_BAR; PG8_SCHED;
            PG8_LDB(B1, 1, 1); PG8_STAGE(PG8_SB(1, 0), b3, voffB);
            PG8_BAR; PG8_WAIT_L(0); PG8_MMA(0, 1, At, B1); PG8_BAR;
            PG8_LDA(At, 1, 1); PG8_STAGE(PG8_SA(1, 0), a3, voffA);
            PG8_BAR; PG8_WAIT_L(0); PG8_MMA(1, 0, At, B0); PG8_BAR; PG8_SCHED;
            PG8_STAGE(PG8_SB(1, 1), b3 + hstep, voffB);
            PG8_WAIT_V(6); PG8_BAR; PG8_MMA(1, 1, At, B1); PG8_BAR;
            }
        }
        if constexpr (ALIGN_EPI) { if (wr == 0) PG8_BAR; }
        if constexpr (!Epi::AFTER_DRAIN) { E(acc, cur, wr, wc, fr, fq); S.done(cur); }
        if (!has_next) break;
#pragma unroll
        for (int a = 0; a < 2; ++a)
#pragma unroll
            for (int b = 0; b < 2; ++b)
#pragma unroll
                for (int m = 0; m < 4; ++m)
#pragma unroll
                    for (int n = 0; n < 2; ++n) acc[a][b][m][n] = (f32x4){0.f, 0.f, 0.f, 0.f};
        cur = nxt; cA = nA; cB = nB; ++ui;
        if constexpr (ALIGN_EPI) { if (wr == 1) PG8_BAR; }
    }
    PG8_WAIT_V(0);
    if constexpr (!ALIGN_EPI) { if (wr == 0) PG8_BAR; }
    PG8_BAR;
    if constexpr (Epi::AFTER_DRAIN) { E.fused(acc, cur, wr, wc, fr, fq, lds, wid, lane); S.done(cur); }
#undef PG8_SA
#undef PG8_SB
#undef PG8_STAGE
#undef PG8_LDA
#undef PG8_LDB
#undef PG8_MMA
#undef PG8_WAIT_V
#undef PG8_WAIT_L
#undef PG8_BAR
#undef PG8_SCHED
}
}

template <int NBLK, int RB, int NPASS, class RowMap, class Epi>
__device__ __forceinline__ void skinny_gemm(const bf16* __restrict__ A, int lda, const bf16* __restrict__ Bt, int K, const RowMap& rm, const Epi& epi, LAS float* part, int rot_seed, int row0) {
    constexpr int ROWS = RB * 16, NC = NBLK * 16, UNR = (RB + NBLK) <= 5 ? 4 : (NBLK <= 2 ? 4 : 2);
    int tid = threadIdx.x; asm volatile("" : "+v"(tid));
    const int w = __builtin_amdgcn_readfirstlane(tid >> 6), lane = tid & 63, r16 = lane & 15, kq = lane >> 4;
    const int Kw = K >> 3, ksteps = Kw >> 5, kbase = w * Kw + 8 * kq, rot = rot_seed % ksteps;
    const bf16* bp[NBLK];
#pragma unroll
    for (int bk = 0; bk < NBLK; ++bk) { const int br = rm(bk, r16); bp[bk] = br >= 0 ? Bt + (size_t)br * K + kbase : nullptr; }
#pragma unroll 1
    for (int pass = 0; pass < NPASS; ++pass) {
        f32x4 acc[RB][NBLK];
#pragma unroll
        for (int rb = 0; rb < RB; ++rb)
#pragma unroll
            for (int bk = 0; bk < NBLK; ++bk) acc[rb][bk] = (f32x4){0.f, 0.f, 0.f, 0.f};
        const bf16* ap = A + (size_t)(row0 + pass * ROWS + r16) * lda + kbase;
#pragma unroll 1
        for (int ks0 = 0; ks0 < ksteps; ks0 += UNR) {
            bf16x8 a[UNR][RB], b[UNR][NBLK];
#pragma unroll
            for (int u = 0; u < UNR; ++u) { int ks = (ks0 + u < ksteps ? ks0 + u : ksteps - 1) + rot; ks = ks >= ksteps ? ks - ksteps : ks;
#pragma unroll
                for (int rb = 0; rb < RB; ++rb) a[u][rb] = *(const GAS bf16x8*)(ap + (size_t)(rb * 16) * lda + 32 * ks);
#pragma unroll
                for (int bk = 0; bk < NBLK; ++bk) { b[u][bk] = (bf16x8){0, 0, 0, 0, 0, 0, 0, 0}; if (bp[bk] && ks0 + u < ksteps) b[u][bk] = *(const GAS bf16x8*)(bp[bk] + 32 * ks); } }
#pragma unroll
            for (int u = 0; u < UNR; ++u)
#pragma unroll
                for (int rb = 0; rb < RB; ++rb)
#pragma unroll
                    for (int bk = 0; bk < NBLK; ++bk) acc[rb][bk] = __builtin_amdgcn_mfma_f32_16x16x32_bf16(a[u][rb], b[u][bk], acc[rb][bk], 0, 0, 0);
        }
        constexpr int NH = (8 * ROWS * NC * 4 > 131072) ? 2 : 1, RBH = RB / NH, ROWSH = RBH * 16;
#pragma unroll
        for (int hf = 0; hf < NH; ++hf) {
            LAS float* pw = part + w * (ROWSH * NC);
#pragma unroll
            for (int rb = 0; rb < RBH; ++rb)
#pragma unroll
                for (int bk = 0; bk < NBLK; ++bk)
#pragma unroll
                    for (int i = 0; i < 4; ++i) pw[(rb * 16 + 4 * kq + i) * NC + bk * 16 + r16] = acc[hf * RBH + rb][bk][i];
            __syncthreads();
            int tid2 = tid; asm volatile("" : "+v"(tid2));
#pragma unroll
            for (int t = 0; t < (ROWSH * 16 + 511) / 512; ++t) { const int pr = tid2 + 512 * t, row = pr >> 4, j = pr & 15; float vals[NBLK]; if (ROWSH * 16 < 512 && pr >= ROWSH * 16) break;
#pragma unroll
                for (int bk = 0; bk < NBLK; ++bk) { float s = 0.f;
#pragma unroll
                    for (int ww = 0; ww < 8; ++ww) s += part[ww * (ROWSH * NC) + row * NC + bk * 16 + j];
                    vals[bk] = s; }
                epi(row0 + pass * ROWS + hf * ROWSH + row, j, vals); }
            __syncthreads();
        }
    }
}
__device__ __forceinline__ float sk_fix(float v, const float* cb, int nrow, float mu, float rstd) { const f32x2 c = *(const GAS f32x2*)(cb + 2 * nrow); return rstd * (v - mu * c[0]) + c[1]; }
struct SkMapLinear { int n0, cnt; __device__ __forceinline__ int operator()(int, int j) const { return j < cnt ? n0 + j : -1; } };
struct SkMapLinear2 { int n0; __device__ __forceinline__ int operator()(int bk, int j) const { return n0 + bk * 16 + j; } };
struct SkEpiResid {
    bf16* X; int n0; float cs, al; const float* sto; const float* g; const float* b; float* stn; int ln;
    __device__ __forceinline__ void operator()(int row, int j, const float (&v)[2]) const { const int r = MP + row; bf16* p = X + (size_t)r * DM + n0 + j;
        float x0 = bf2f(p[0]), x1 = bf2f(p[16]);
        if (ln) { float mu, rstd; pg8::row_mu_rstd(sto, r, mu, rstd); x0 = (x0 - mu) * rstd * g[n0 + j] + b[n0 + j]; x1 = (x1 - mu) * rstd * g[n0 + 16 + j] + b[n0 + 16 + j]; }
        const float y0 = x0 * al + cs * v[0], y1 = x1 * al + cs * v[1]; p[0] = (bf16)f2bf(y0); p[16] = (bf16)f2bf(y1);
        float s1 = y0 + y1, s2 = y0 * y0 + y1 * y1;
#pragma unroll
        for (int o = 1; o < 16; o <<= 1) { s1 += __shfl_xor(s1, o); s2 += __shfl_xor(s2, o); }
        if (j == 0) { atomicAdd(stn + 2 * (size_t)r, s1); atomicAdd(stn + 2 * (size_t)r + 1, s2); } }
};
struct SkMapSwiglu { int h0;
    __device__ __forceinline__ int operator()(int bk, int j) const { const int i = (bk >> 1) * 16 + j; if (i >= 22) return -1; const int hh = h0 + i; return (hh >> 7) * 256 + (hh & 127) + (bk & 1) * 128; } };
struct SkEpiSwiglu { bf16* H; int h0; const float* st; const float* cb; int ln;
    __device__ __forceinline__ void operator()(int row, int j, const float (&v)[4]) const {
        bf16* p = H + (size_t)(MP + row) * DFF + h0; float mu = 0.f, rstd = 1.f; if (ln) pg8::row_mu_rstd(st, MP + row, mu, rstd);
        { const int hh = h0 + j, nr = (hh >> 7) * 256 + (hh & 127); float g = v[0], u = v[1]; if (ln) { g = sk_fix(g, cb, nr, mu, rstd); u = sk_fix(u, cb, nr + 128, mu, rstd); }
          const float e = __builtin_amdgcn_exp2f(g * -1.4426950408889634f); p[j] = (bf16)f2bf(g * __builtin_amdgcn_rcpf(1.0f + e) * u); }
        if (j < 6) { const int hh = h0 + 16 + j, nr = (hh >> 7) * 256 + (hh & 127); float g = v[2], u = v[3]; if (ln) { g = sk_fix(g, cb, nr, mu, rstd); u = sk_fix(u, cb, nr + 128, mu, rstd); }
          const float e = __builtin_amdgcn_exp2f(g * -1.4426950408889634f); p[16 + j] = (bf16)f2bf(g * __builtin_amdgcn_rcpf(1.0f + e) * u); } }
};
struct SkEpiInB { unsigned char* ws; float* out; int n0; const float* st; const float* cb;
    __device__ __forceinline__ void operator()(int row, int j, const float (&v)[1]) const { if (j >= 12) return; const int n = n0 + j; const size_t r = (size_t)MP + row; float mu, rstd; pg8::row_mu_rstd(st, MP + row, mu, rstd); const float x = sk_fix(v[0], cb, n, mu, rstd);
        if (n < NQ) ((bf16*)(ws + WS_R1 + R1_Q))[r * NQ + n] = (bf16)f2bf(x);
        else if (n < NQ + 2 * NKV) { const int isv = n >= NQ + NKV, c = n - NQ - isv * NKV; ((bf16*)(ws + WS_R1 + (isv ? R1_V : R1_K)))[r * NKV + c] = (bf16)f2bf(x);
            out[(isv ? O_BVS : O_BKS) + ((size_t)(row >> 4) * 512 + (BBUF - DS) + (row & 15)) * 512 + c] = x; }
        else ((bf16*)(ws + WS_R1 + R1_QM))[r * NMQ + (n - NQ - 2 * NKV)] = (bf16)f2bf(x); }
};
__device__ __forceinline__ int ska_pair_row(int p, int x2) {
    int tile, lc;
    if (p < 768) { const int h = p >> 6, d = p & 63; tile = h >> 1; lc = (h & 1) * 64 + d; }
    else if (p < 1024) { const int pp = p - 768, h = pp >> 6, d = pp & 63; tile = 6 + (h >> 1); lc = (h & 1) * 64 + d; }
    else if (p < 1280) { const int pp = p - 1024, h = pp >> 5, d = pp & 31; tile = 12 + (h >> 2); lc = (h & 3) * 32 + d; }
    else { tile = 14; lc = p - 1280; }
    return tile * 256 + lc + x2 * 128; }
struct SkMapInA { int wg;
    __device__ __forceinline__ int operator()(int bk, int j) const {
        if (j < 6) { const int p = 6 * wg + j; return p < 1312 ? ska_pair_row(p, bk) : -1; }
        if (bk == 1 || j >= 11) return -1;
        const int s = 5 * wg + (j - 6); if (s >= 1032) return -1;
        return s < 1024 ? 2048 + s : 14 * 256 + 32 + (s - 1024); } };
struct SkEpiInA { unsigned char* ws; float* out; int wg; const float* st; const float* cb;
    __device__ __forceinline__ void operator()(int row, int j, const float (&vin)[2]) const {
        const size_t r = (size_t)MP + row; const int pos = PAST + (row & 15); float mu, rstd; pg8::row_mu_rstd(st, MP + row, mu, rstd); float v[2] = {vin[0], vin[1]};
        if (j < 6) { const int p = 6 * wg + j; if (p < 1312) { v[0] = sk_fix(v[0], cb, ska_pair_row(p, 0), mu, rstd); v[1] = sk_fix(v[1], cb, ska_pair_row(p, 1), mu, rstd); } }
        else if (j < 11) { const int s = 5 * wg + (j - 6); if (s < 1032) v[0] = sk_fix(v[0], cb, s < 1024 ? 2048 + s : 14 * 256 + 32 + (s - 1024), mu, rstd); }
        if (j < 6) { const int p = 6 * wg + j; if (p >= 1312) return;
            if (p < 1024) { const int isk = p >= 768, pp = isk ? p - 768 : p, h = pp >> 6, d = pp & 63;
                const float c = ((const float*)(ws + WS_COS128))[pos * 64 + d], s = ((const float*)(ws + WS_SIN128))[pos * 64 + d];
                const float o1 = v[0] * c - v[1] * s, o2 = v[1] * c + v[0] * s;
                if (!isk) { bf16* q = (bf16*)(ws + WS_R1 + R1_Q) + r * NQ + h * 128 + d; q[0] = (bf16)f2bf(o1); q[64] = (bf16)f2bf(o2); }
                else { bf16* k = (bf16*)(ws + WS_R1 + R1_K) + r * NKV + h * 128 + d; k[0] = (bf16)f2bf(o1); k[64] = (bf16)f2bf(o2); float* o = out + O_AKS + (size_t)row * 512 + h * 128 + d; o[0] = o1; o[64] = o2; } }
            else { const int isk = p >= 1280, pp = isk ? p - 1280 : p - 1024, h = isk ? 0 : pp >> 5, d = pp & 31;
                const float c = ((const float*)(ws + WS_COS64))[pos * 32 + d], s = ((const float*)(ws + WS_SIN64))[pos * 32 + d];
                const float o1 = v[0] * c - v[1] * s, o2 = v[1] * c + v[0] * s;
                if (!isk) { bf16* q = (bf16*)(ws + WS_R1 + R1_QI) + r * NIQ + h * 64 + d; q[0] = (bf16)f2bf(o1); q[32] = (bf16)f2bf(o2); }
                else { bf16* k = (bf16*)(ws + WS_R1 + R1_KI); k[ki_tiled(r, d)] = (bf16)f2bf(o1); k[ki_tiled(r, d + 32)] = (bf16)f2bf(o2); float* o = out + O_AIS + (size_t)row * 64 + d; o[0] = o1; o[32] = o2; } }
        } else if (j < 11) { const int s = 5 * wg + (j - 6); if (s >= 1032) return; const float x = v[0];
            if (s < 512) { ((bf16*)(ws + WS_R1 + R1_V))[r * NKV + s] = (bf16)f2bf(x); out[O_AVS + (size_t)row * 512 + s] = x; }
            else if (s < 1024) ((bf16*)(ws + WS_R1 + R1_QM))[r * NMQ + (s - 512)] = (bf16)f2bf(x);
            else ((float*)(ws + WS_R1 + R1_WI))[r * NIH + (s - 1024)] = x; }
    }
};

struct Params { const float* in[21]; float* out; unsigned char* ws; int ph_lo, ph_hi; };
struct Frame {
    LAS unsigned char* lds;
    int tid, lane, wave, G, bx;
    const Params* P; float* out; unsigned char* ws;
};
enum { IN_XP = 0, IN_XS, IN_MEMP, IN_CAK, IN_CAV, IN_CAI, IN_CBK, IN_CBV, IN_CMK, IN_CMV, IN_WINA, IN_WINB, IN_WO, IN_RELB, IN_WMEM, IN_F1I, IN_F1O, IN_F2I, IN_F2O, IN_LNG, IN_LNB };

enum { TM_ID = 0, TM_FFN_IN = 1, TM_INA = 2 };
__device__ __forceinline__ int srcmap(int mode, int n) {
    if (mode == TM_ID) return n;
    const int tile = n >> 8, w = n & 255, half = w >> 7, lc = w & 127;
    if (mode == TM_FFN_IN) return half ? DFF + tile * 128 + lc : tile * 128 + lc;
    if (tile < 6) return (2 * tile + (lc >> 6)) * 128 + (lc & 63) + 64 * half;
    if (tile < 8) return NQ + (2 * (tile - 6) + (lc >> 6)) * 128 + (lc & 63) + 64 * half;
    if (tile < 12) return n;
    if (tile < 14) return 3072 + (4 * (tile - 12) + (lc >> 5)) * 64 + (lc & 31) + 32 * half;
    if (lc < 32) return 3584 + lc + 32 * half;
    if (half == 0 && lc < 40) return 3648 + (lc - 32);
    return -1;
}
struct TpItem { const float* W; int K, N; bf16* WT; int mode, item, nblk; const float* gk; const float* bk; float* cbo; };
__device__ __forceinline__ void tp_load(const TpItem& d, int lane, f32x4 (&v)[16]) {
    const int kb = d.item / d.nblk, nb = d.item % d.nblk, k0 = 64 * kb, n0 = 64 * nb, n4 = (lane & 15) * 4, src = srcmap(d.mode, n0 + n4);
#pragma unroll
    for (int i = 0; i < 16; ++i) { const int kk = 4 * i + (lane >> 4); v[i] = (f32x4){0.f, 0.f, 0.f, 0.f};
        if (src >= 0) v[i] = *(const GAS f32x4*)(d.W + (size_t)(k0 + kk) * d.N + src); }
}
__device__ __forceinline__ void tp_to_lds(const TpItem& d, int lane, f32x4 (&v)[16], LAS float* scr) {
    const int kb = d.item / d.nblk, nb = d.item % d.nblk, k0 = 64 * kb, n0 = 64 * nb, n4 = (lane & 15) * 4;
    f32x4 csp = {0.f, 0.f, 0.f, 0.f}, bwp = {0.f, 0.f, 0.f, 0.f};
#pragma unroll
    for (int i = 0; i < 16; ++i) { const int kk = 4 * i + (lane >> 4); f32x4 x = v[i];
        if (d.gk) { const float gg = d.gk[k0 + kk], bb = d.bk[k0 + kk]; bwp += x * bb; x = x * gg;
            csp[0] += bf2f((bf16)f2bf(x[0])); csp[1] += bf2f((bf16)f2bf(x[1])); csp[2] += bf2f((bf16)f2bf(x[2])); csp[3] += bf2f((bf16)f2bf(x[3])); }
        LAS float* q = scr + kk * 65 + n4; q[0] = x[0]; q[1] = x[1]; q[2] = x[2]; q[3] = x[3]; }
    if (d.gk) {
#pragma unroll
        for (int e = 0; e < 4; ++e) { csp[e] += __shfl_xor(csp[e], 16); csp[e] += __shfl_xor(csp[e], 32); bwp[e] += __shfl_xor(bwp[e], 16); bwp[e] += __shfl_xor(bwp[e], 32); }
        if (lane < 16) {
#pragma unroll
            for (int e = 0; e < 4; ++e) { atomicAdd(d.cbo + 2 * (n0 + n4 + e), csp[e]); atomicAdd(d.cbo + 2 * (n0 + n4 + e) + 1, bwp[e]); } } }
}
__device__ __forceinline__ void tp_from_lds(const TpItem& d, int lane, LAS float* scr) {
    const int kb = d.item / d.nblk, nb = d.item % d.nblk, k0 = 64 * kb, n0 = 64 * nb, c = lane & 7;
    LDS_WAIT(); asm volatile("" ::: "memory");
#pragma unroll
    for (int j = 0; j < 8; ++j) { const int n = (lane >> 3) + 8 * j; const LAS float* sp = scr + (8 * c) * 65 + n;
        u32x4 o; o.x = pk2(sp[0 * 65], sp[1 * 65]); o.y = pk2(sp[2 * 65], sp[3 * 65]); o.z = pk2(sp[4 * 65], sp[5 * 65]); o.w = pk2(sp[6 * 65], sp[7 * 65]);
        *(GAS u32x4*)(d.WT + (size_t)(n0 + n) * d.K + k0 + 8 * c) = o; }
    LDS_WAIT(); asm volatile("" ::: "memory");
}
__device__ __forceinline__ TpItem tp_decode(Frame& F, int it) {
    unsigned char* ws = F.ws;
    constexpr int I_FI = (DM / 64) * (NFF2 / 64), I_FO = (DFF / 64) * (DM / 64), I_INA = (DM / 64) * (PROJ_A_PAD / 64), I_INB = (DM / 64) * (PROJ_B / 64), I_O = (DM / 64) * (DM / 64), I_MEM = (DM / 64) * (1024 / 64);
    int r = it; TpItem d;
    if (r < 4 * I_FI) { const int w = r / I_FI, l = w >> 1, f = w & 1; r -= w * I_FI;
        const int gi = w == 1 ? 1 : w == 2 ? 2 : 4;
        d = TpItem{(f ? F.P->in[IN_F2I] : F.P->in[IN_F1I]) + (size_t)l * DM * NFF2, DM, NFF2, (bf16*)(ws + WS_WFI + (size_t)w * 44 * MiB), TM_FFN_IN, r, NFF2 / 64,
                   w ? F.P->in[IN_LNG] + (size_t)gi * DM : nullptr, w ? F.P->in[IN_LNB] + (size_t)gi * DM : nullptr, (float*)(ws + CTL_CSBW) + (size_t)(w ? w - 1 : 0) * CSBW_STRIDE}; return d; } r -= 4 * I_FI;
    if (r < 4 * I_FO) { const int w = r / I_FO, l = w >> 1, f = w & 1; r -= w * I_FO;
        d = TpItem{(f ? F.P->in[IN_F2O] : F.P->in[IN_F1O]) + (size_t)l * DFF * DM, DFF, DM, (bf16*)(ws + WS_WFO + (size_t)w * 22 * MiB), TM_ID, r, DM / 64, nullptr, nullptr, nullptr}; return d; } r -= 4 * I_FO;
    if (r < I_INA) { d = TpItem{F.P->in[IN_WINA], DM, PROJ_A, (bf16*)(ws + WS_WINA), TM_INA, r, PROJ_A_PAD / 64, F.P->in[IN_LNG], F.P->in[IN_LNB], (float*)(ws + CTL_CSBW) + (size_t)FM_INA * CSBW_STRIDE}; return d; } r -= I_INA;
    if (r < I_INB) { d = TpItem{F.P->in[IN_WINB], DM, PROJ_B, (bf16*)(ws + WS_WINB), TM_ID, r, PROJ_B / 64, F.P->in[IN_LNG] + 3 * DM, F.P->in[IN_LNB] + 3 * DM, (float*)(ws + CTL_CSBW) + (size_t)FM_INB * CSBW_STRIDE}; return d; } r -= I_INB;
    if (r < 2 * I_O) { const int l = r / I_O; r -= l * I_O; d = TpItem{F.P->in[IN_WO] + (size_t)l * DM * DM, DM, DM, (bf16*)(ws + WS_WO + (size_t)l * 8 * MiB), TM_ID, r, DM / 64, nullptr, nullptr, nullptr}; return d; } r -= 2 * I_O;
    { const int l = r / I_MEM; r -= l * I_MEM; d = TpItem{F.P->in[IN_WMEM] + (size_t)l * DM * 1024, DM, 1024, (bf16*)(ws + WS_WMEM) + (size_t)l * 1024 * DM, TM_ID, r, 1024 / 64, nullptr, nullptr, nullptr}; return d; }
}
__device__ __forceinline__ void p0_prologue(Frame& F) {
    LAS float* scr = (LAS float*)(F.lds + F.wave * 16640);
    const int gw = F.bx * NWAVES + F.wave, NGW = F.G * NWAVES;
    unsigned char* ws = F.ws;
    constexpr int NITEMS = 4 * ((DM / 64) * (NFF2 / 64)) + 4 * ((DFF / 64) * (DM / 64)) + (DM / 64) * (PROJ_A_PAD / 64) + (DM / 64) * (PROJ_B / 64) + 2 * ((DM / 64) * (DM / 64)) + 2 * ((DM / 64) * (1024 / 64));
    if (gw < NITEMS) {
        TpItem cur = tp_decode(F, gw); f32x4 v[16]; tp_load(cur, F.lane, v);
        for (int it = gw; it < NITEMS; it += NGW) {
            tp_to_lds(cur, F.lane, v, scr);
            const bool has = it + NGW < NITEMS; TpItem nx = cur;
            if (has) { nx = tp_decode(F, it + NGW); tp_load(nx, F.lane, v); }
            tp_from_lds(cur, F.lane, scr);
            cur = nx;
        }
    }
    { const int gt = F.bx * (NWAVES * 64) + F.tid, NGT = F.G * NWAVES * 64; f32x4* z = (f32x4*)(ws + WS_STATS); for (int i = gt; i < (int)(6 * (size_t)MPAD * 2 / 4); i += NGT) z[i] = (f32x4){0.f, 0.f, 0.f, 0.f}; }
    for (int m = gw; m < MPAD + NB * NMEM; m += NGW) {
        const float* src; bf16* dst;
        if (m < MP) { src = F.P->in[IN_XP] + (size_t)m * DM; dst = (bf16*)(ws + WS_X) + (size_t)m * DM; }
        else if (m < MR) { src = F.P->in[IN_XS] + (size_t)(m - MP) * DM; dst = (bf16*)(ws + WS_X) + (size_t)m * DM; }
        else if (m < MPAD) { src = nullptr; dst = (bf16*)(ws + WS_X) + (size_t)m * DM; }
        else { src = F.P->in[IN_MEMP] + (size_t)(m - MPAD) * DM; dst = (bf16*)(ws + WS_MEMB) + (size_t)(m - MPAD) * DM; }
#pragma unroll
        for (int j = 0; j < 4; ++j) { const int e = 512 * j + 8 * F.lane; u32x4 o = {0u, 0u, 0u, 0u};
            if (src) { const f32x4 a = *(const GAS f32x4*)(src + e), b = *(const GAS f32x4*)(src + e + 4); o.x = pk2(a[0], a[1]); o.y = pk2(a[2], a[3]); o.z = pk2(b[0], b[1]); o.w = pk2(b[2], b[3]); }
            *(GAS u32x4*)(dst + e) = o; }
    }
    { float* c128 = (float*)(ws + WS_COS128); float* s128 = (float*)(ws + WS_SIN128); float* c64 = (float*)(ws + WS_COS64); float* s64 = (float*)(ws + WS_SIN64);
      const int gt = F.bx * (NWAVES * 64) + F.tid, NGT = F.G * NWAVES * 64;
      for (int i = gt; i < SEQ * 96; i += NGT) { const int pos = i / 96, j = i % 96;
          const int half = j < 64 ? 64 : 32, fi = j < 64 ? j : j - 64;
          const float ex = -(float)fi / (float)half; const float invf = (float)pow(10000.0, (double)ex); const float ang = (float)pos * invf;
          const float cv = (float)cos((double)ang), sv = (float)sin((double)ang);
          if (j < 64) { c128[pos * 64 + fi] = cv; s128[pos * 64 + fi] = sv; } else { c64[pos * 32 + fi] = cv; s64[pos * 32 + fi] = sv; } } }
    { const int gt = F.bx * (NWAVES * 64) + F.tid, NGT = F.G * NWAVES * 64; constexpr int PER = (BBUF - DS) * 512 / 4;
      for (int i = gt; i < 2 * DB * PER; i += NGT) { const int kv = i / (DB * PER), r = i % (DB * PER), b = r / PER, e = r % PER;
          const f32x4 vv = *(const GAS f32x4*)((kv ? F.P->in[IN_CBV] : F.P->in[IN_CBK]) + ((size_t)b * BBUF + DS) * 512 + (size_t)e * 4);
          *(GAS f32x4*)(F.out + (kv ? O_BVS : O_BKS) + (size_t)b * BBUF * 512 + (size_t)e * 4) = vv; } }
}

__device__ __forceinline__ void ln_phase(Frame& F, const float* g, const float* b, float* yout, float ys_scale = 1.0f) {
    const int gw = F.bx * NWAVES + F.wave, NGW = F.G * NWAVES;
    bf16* X = (bf16*)(F.ws + WS_X);
    f32x4 gg[4][2], bb[4][2];
#pragma unroll
    for (int j = 0; j < 4; ++j) { const int e = 512 * j + 8 * F.lane; gg[j][0] = *(const GAS f32x4*)(g + e); gg[j][1] = *(const GAS f32x4*)(g + e + 4); bb[j][0] = *(const GAS f32x4*)(b + e); bb[j][1] = *(const GAS f32x4*)(b + e + 4); }
    const int nrows = MR;
    for (int m0 = 2 * gw; m0 < nrows; m0 += 2 * NGW) {
        f32x4 v[2][4][2]; float s[2] = {0.f, 0.f};
#pragma unroll
        for (int r = 0; r < 2; ++r) { const int m = (m0 + r < nrows) ? m0 + r : m0; const bf16* xr = X + (size_t)m * DM;
#pragma unroll
            for (int j = 0; j < 4; ++j) { const u32x4 w = *(const GAS u32x4*)(xr + 512 * j + 8 * F.lane);
                v[r][j][0][0] = __builtin_bit_cast(float, w.x << 16); v[r][j][0][1] = __builtin_bit_cast(float, w.x & 0xffff0000u); v[r][j][0][2] = __builtin_bit_cast(float, w.y << 16); v[r][j][0][3] = __builtin_bit_cast(float, w.y & 0xffff0000u);
                v[r][j][1][0] = __builtin_bit_cast(float, w.z << 16); v[r][j][1][1] = __builtin_bit_cast(float, w.z & 0xffff0000u); v[r][j][1][2] = __builtin_bit_cast(float, w.w << 16); v[r][j][1][3] = __builtin_bit_cast(float, w.w & 0xffff0000u); } }
#pragma unroll
        for (int r = 0; r < 2; ++r)
#pragma unroll
            for (int j = 0; j < 4; ++j)
#pragma unroll
                for (int h = 0; h < 2; ++h) s[r] += (v[r][j][h][0] + v[r][j][h][1]) + (v[r][j][h][2] + v[r][j][h][3]);
#pragma unroll
        for (int r = 0; r < 2; ++r) { const int m = m0 + r; if (m >= nrows) break;
            bf16* xr = X + (size_t)m * DM;
            const float mean = wave_sum(s[r]) * (1.f / DM); float s2 = 0.f;
#pragma unroll
            for (int j = 0; j < 4; ++j)
#pragma unroll
                for (int h = 0; h < 2; ++h) { v[r][j][h] = v[r][j][h] - mean; s2 += (v[r][j][h][0] * v[r][j][h][0] + v[r][j][h][1] * v[r][j][h][1]) + (v[r][j][h][2] * v[r][j][h][2] + v[r][j][h][3] * v[r][j][h][3]); }
            const float rstd = 1.f / sqrtf(wave_sum(s2) * (1.f / DM) + LN_EPS);
#pragma unroll
            for (int j = 0; j < 4; ++j) { const f32x4 o0 = v[r][j][0] * rstd * gg[j][0] + bb[j][0], o1 = v[r][j][1] * rstd * gg[j][1] + bb[j][1];
                if (yout) { float* yo = yout + (m < MP ? O_YP + (size_t)m * DM : O_YS + (size_t)(m - MP) * DM) + 512 * j + 8 * F.lane; const float sc_ = m < MP ? 1.0f : ys_scale; *(GAS f32x4*)yo = o0 * sc_; *(GAS f32x4*)(yo + 4) = o1 * sc_; }
                else { u32x4 o; o.x = cvt_pk_bf16(o0[0], o0[1]); o.y = cvt_pk_bf16(o0[2], o0[3]); o.z = cvt_pk_bf16(o1[0], o1[1]); o.w = cvt_pk_bf16(o1[2], o1[3]); *(GAS u32x4*)(xr + 512 * j + 8 * F.lane) = o; } } }
    }
}

template <class Sched>
__device__ __forceinline__ void stats_finalize_local(Frame& F, const Sched& S, const float* part, float* st) {
    int pa = -1, pb = -1; pg8::Unit u;
    for (int i = 0;; ++i) { const bool more = S.next(i, u); bool flush = !more;
        if (more && u.pm != pa && u.pm != pb) { if (pa < 0) pa = u.pm; else if (pb < 0) pb = u.pm; else { flush = true; --i; } }
        if (flush) { const int pm = (F.tid >> 8) ? pb : pa;
            if (pm >= 0) { const size_t row = (size_t)pm * 256 + (F.tid & 255); const float* pr = part + row * 64; f32x4 v[16];
#pragma unroll
                for (int k = 0; k < 16; ++k) v[k] = *(const GAS f32x4*)(pr + 4 * k);
                float s1 = 0.f, s2 = 0.f;
#pragma unroll
                for (int k = 0; k < 16; ++k) { s1 += v[k][0] + v[k][2]; s2 += v[k][1] + v[k][3]; }
                *(GAS f32x2*)(st + 2 * row) = (f32x2){s1, s2}; }
            pa = pb = -1; }
        if (!more) break; }
    __syncthreads();
}

__device__ __forceinline__ void stats_finalize(Frame& F, const float* part, float* st) {
    const int gw = F.bx * NWAVES + F.wave, NGW = F.G * NWAVES, half = F.lane >> 5, sl = F.lane & 31;
    for (int r0 = 2 * gw; r0 < MP; r0 += 2 * NGW) { const int row = r0 + half;
        f32x2 v = *(const GAS f32x2*)(part + ((size_t)row * 32 + sl) * 2);
#pragma unroll
        for (int o = 1; o < 32; o <<= 1) { v[0] += __shfl_xor(v[0], o); v[1] += __shfl_xor(v[1], o); }
        if (sl == 0) *(GAS f32x2*)(st + 2 * (size_t)row) = v; }
}


namespace att {
constexpr int D = 128, NW = 8, QBLK = 32, KVBLK = 64, LDK = 512, LDO = DM;
constexpr float SCALE = ATT_SCALE, THR = 8.f;
constexpr int SHM_V = KVBLK * D * 2, SHM_K = KVBLK * D * 2, SHM_WS = 2 * SHM_V + 2 * SHM_K, SHM_TBL = SHM_WS + NW * 64 * 4, SHM_ATTN = SHM_TBL + 260 * 4;
#define KSWZ(row, colB) ((row) * 256 + ((colB) ^ (((row) & 7) << 4)))
#define SBAR() __builtin_amdgcn_sched_barrier(0)
__device__ __forceinline__ int crow(int r, int hi) { return (r & 3) + 8 * (r >> 2) + 4 * hi; }
__device__ __forceinline__ unsigned cvtpk(float lo, float hi) { unsigned r; asm volatile("v_cvt_pk_bf16_f32 %0, %1, %2" : "=v"(r) : "v"(lo), "v"(hi)); return r; }

__device__ __forceinline__ void partialSM(f32x16& p0, f32x16& p1, float& m_reg, float& mn, float& alpha) {
  constexpr float C = SCALE * 1.4426950408889634f;
  float pmax = p0[0];
#pragma unroll
  for (int r = 1; r < 16; ++r) pmax = fmaxf(pmax, p0[r]);
#pragma unroll
  for (int r = 0; r < 16; ++r) pmax = fmaxf(pmax, p1[r]);
  { auto rr = __builtin_amdgcn_permlane32_swap(__float_as_uint(pmax), __float_as_uint(pmax), false, false);
    pmax = fmaxf(__uint_as_float(rr[0]), __uint_as_float(rr[1])); }
  if (__builtin_expect(__all(pmax - m_reg <= THR / SCALE), 1)) { mn = m_reg; alpha = 1.f; }
  else { mn = fmaxf(m_reg, pmax); alpha = __builtin_amdgcn_exp2f((m_reg - mn) * C); m_reg = mn; }
  float mnC = -mn * C;
  { const f32x2 c2 = {C, C}, m2 = {mnC, mnC};
#pragma unroll
    for (int r = 0; r < 16; r += 2) { f32x2 t = {p0[r], p0[r + 1]}, u = {p1[r], p1[r + 1]};
      asm("v_pk_fma_f32 %0, %1, %2, %3" : "=v"(t) : "v"(t), "v"(c2), "v"(m2)); asm("v_pk_fma_f32 %0, %1, %2, %3" : "=v"(u) : "v"(u), "v"(c2), "v"(m2));
      p0[r] = t[0]; p0[r + 1] = t[1]; p1[r] = u[0]; p1[r + 1] = u[1]; } }
#pragma unroll
  for (int r = 0; r < 16; ++r) p0[r] = __builtin_amdgcn_exp2f(p0[r]);
}
template <int MODE>
__device__ __forceinline__ void finishSM(f32x16& p0, f32x16& p1, bf16x8& pa0, bf16x8& pa1, bf16x8& pa2, bf16x8& pa3, unsigned mw0, unsigned mw1) {
#pragma unroll
  for (int r = 0; r < 16; ++r) p1[r] = __builtin_amdgcn_exp2f(p1[r]);
#define PMSK(x, W, SH) do { if (MODE == 2) { unsigned t_; asm("v_pk_lshlrev_b16 %0, " #SH ", %1 op_sel_hi:[0,1]" : "=v"(t_) : "v"(W)); asm("v_pk_ashrrev_i16 %0, 15, %1 op_sel_hi:[0,1]" : "=v"(t_) : "v"(t_)); x &= t_; } } while (0)
#define PK4(P, BASE, OUT, W, S0, S1, S2, S3) do { unsigned a0 = cvtpk(P[BASE + 0], P[BASE + 1]), a1 = cvtpk(P[BASE + 2], P[BASE + 3]);   \
    unsigned b0 = cvtpk(P[BASE + 4], P[BASE + 5]), b1 = cvtpk(P[BASE + 6], P[BASE + 7]);                              \
    PMSK(a0, W, S0); PMSK(a1, W, S1); PMSK(b0, W, S2); PMSK(b1, W, S3);                                               \
    auto r0 = __builtin_amdgcn_permlane32_swap(a0, b0, false, false); auto r1 = __builtin_amdgcn_permlane32_swap(a1, b1, false, false); \
    u32x4 w = {r0[0], r1[0], r0[1], r1[1]}; OUT = *reinterpret_cast<bf16x8*>(&w); } while (0)
  PK4(p0, 0, pa0, mw0, 15, 14, 11, 10); PK4(p0, 8, pa1, mw0, 7, 6, 3, 2); PK4(p1, 0, pa2, mw1, 15, 14, 11, 10); PK4(p1, 8, pa3, mw1, 7, 6, 3, 2);
#undef PK4
#undef PMSK
}
__device__ __forceinline__ void qkt(f32x16& p0, f32x16& p1, const bf16* Ks, const bf16x8* qr, int r32, int hi) {
  p0 = f32x16{}; p1 = f32x16{};
#pragma unroll
  for (int d0 = 0; d0 < 8; ++d0) { int cb = (d0 * 16 + hi * 8) * 2;
    bf16x8 b0 = *reinterpret_cast<const bf16x8*>((const char*)Ks + KSWZ(r32, cb));
    bf16x8 b1 = *reinterpret_cast<const bf16x8*>((const char*)Ks + KSWZ(32 + r32, cb));
    p0 = __builtin_amdgcn_mfma_f32_32x32x16_bf16(b0, qr[d0], p0, 0, 0, 0);
    p1 = __builtin_amdgcn_mfma_f32_32x32x16_bf16(b1, qr[d0], p1, 0, 0, 0); }
}
__device__ __forceinline__ int v_st(int k, int c) { const int kk = (k & ~0xC) | ((k & 4) << 1) | ((k & 8) >> 1); return ((kk >> 3) * 4 + (c >> 5)) * 512 + ((kk & 7) * 32 + (c & 31)) * 2; }
__device__ __forceinline__ int v_rd_base(int lane) { return ((lane & 3) << 3) | (((lane >> 2) & 3) << 6) | (((lane >> 4) & 1) << 5) | (((lane >> 5) & 1) << 8); }
constexpr int v_rd_off(int d0, int ks, int half) { return d0 * 512 + ks * 4096 + half * 2048; }
template <int OFF> __device__ __forceinline__ s16x4 tr_read(int vb) {
  s16x4 r; asm volatile("ds_read_b64_tr_b16 %0, %1 offset:%2" : "=&v"(r) : "v"(vb), "i"(OFF) : "memory"); return r;
}
template <int D0> __device__ __forceinline__ void pv_one(f32x16& od, int vb, bf16x8 pa0, bf16x8 pa1, bf16x8 pa2, bf16x8 pa3) {
  const s16x4 l0 = tr_read<v_rd_off(D0, 0, 0)>(vb), h0 = tr_read<v_rd_off(D0, 0, 1)>(vb), l1 = tr_read<v_rd_off(D0, 1, 0)>(vb), h1 = tr_read<v_rd_off(D0, 1, 1)>(vb);
  const s16x4 l2 = tr_read<v_rd_off(D0, 2, 0)>(vb), h2 = tr_read<v_rd_off(D0, 2, 1)>(vb), l3 = tr_read<v_rd_off(D0, 3, 0)>(vb), h3 = tr_read<v_rd_off(D0, 3, 1)>(vb);
  asm volatile("s_waitcnt lgkmcnt(0)" ::: "memory"); SBAR();
#define PK(L, H) (bf16x8){L[0], L[1], L[2], L[3], H[0], H[1], H[2], H[3]}
  od = __builtin_amdgcn_mfma_f32_32x32x16_bf16(pa0, PK(l0, h0), od, 0, 0, 0);
  od = __builtin_amdgcn_mfma_f32_32x32x16_bf16(pa1, PK(l1, h1), od, 0, 0, 0);
  od = __builtin_amdgcn_mfma_f32_32x32x16_bf16(pa2, PK(l2, h2), od, 0, 0, 0);
  od = __builtin_amdgcn_mfma_f32_32x32x16_bf16(pa3, PK(l3, h3), od, 0, 0, 0);
#undef PK
}
__device__ __forceinline__ void pv_d0(f32x16* o, int vb, bf16x8 pa0, bf16x8 pa1, bf16x8 pa2, bf16x8 pa3) {
  const bf16x8 ones = {0x3F80, 0x3F80, 0x3F80, 0x3F80, 0x3F80, 0x3F80, 0x3F80, 0x3F80};
  o[4] = __builtin_amdgcn_mfma_f32_32x32x16_bf16(pa0, ones, o[4], 0, 0, 0); o[4] = __builtin_amdgcn_mfma_f32_32x32x16_bf16(pa1, ones, o[4], 0, 0, 0);
  o[4] = __builtin_amdgcn_mfma_f32_32x32x16_bf16(pa2, ones, o[4], 0, 0, 0); o[4] = __builtin_amdgcn_mfma_f32_32x32x16_bf16(pa3, ones, o[4], 0, 0, 0);
  pv_one<0>(o[0], vb, pa0, pa1, pa2, pa3); pv_one<1>(o[1], vb, pa0, pa1, pa2, pa3); pv_one<2>(o[2], vb, pa0, pa1, pa2, pa3); pv_one<3>(o[3], vb, pa0, pa1, pa2, pa3);
}

template <int MODE, int LDQ, int SDEPTH>
__device__ __forceinline__ void attn_unit(const bf16* __restrict__ Qb, const bf16* __restrict__ Kh, const bf16* __restrict__ Vh, bf16* __restrict__ Ob, int NT, int mp,
                                          const unsigned* __restrict__ mrow, char* lds) {
  int tid = threadIdx.x; asm volatile("" : "+v"(tid));
  const int wid = tid >> 6, lane = tid & 63, r32 = lane & 31, hi = lane >> 5, cc = wid >> 1;
  if (MODE == 2) mrow += (32 * wid + r32) * 2;
  bf16* V_lds = (bf16*)lds; bf16* K_lds = (bf16*)(lds + 2 * SHM_V);
  float* ws = (float*)(lds + SHM_WS) + wid * 64; float* al_l = ws + 32;
  const float* tbl = (const float*)(lds + SHM_TBL);
  float m_reg = -1e30f; f32x16 o[5] = {}; bf16x8 qr[8];
  const bf16* Qw = Qb + (long)(wid * QBLK + r32) * LDQ + hi * 8;
#pragma unroll
  for (int d0 = 0; d0 < 8; ++d0) qr[d0] = *reinterpret_cast<const bf16x8*>(Qw + d0 * 16);
  const int sr = tid >> 4, sc = (tid & 15) * 8, vst0 = v_st(sr, sc), vst1 = v_st(32 + sr, sc);
  const int vb0 = (int)(uintptr_t)V_lds + v_rd_base(lane);
  struct { bf16x8 vs0, vs1, ks0, ks1; } sr_[SDEPTH];
#define SLOAD(i, k0) do { sr_[i].vs0 = *reinterpret_cast<const bf16x8*>(&Vh[(long)((k0) + sr) * LDK + sc]); sr_[i].vs1 = *reinterpret_cast<const bf16x8*>(&Vh[(long)((k0) + 32 + sr) * LDK + sc]); \
    sr_[i].ks0 = *reinterpret_cast<const bf16x8*>(&Kh[(long)((k0) + sr) * LDK + sc]); sr_[i].ks1 = *reinterpret_cast<const bf16x8*>(&Kh[(long)((k0) + 32 + sr) * LDK + sc]); } while (0)
#define SWRITE(b, i) do { *(bf16x8*)((char*)V_lds + (b) * SHM_V + vst0) = sr_[i].vs0;          \
    *(bf16x8*)((char*)V_lds + (b) * SHM_V + vst1) = sr_[i].vs1; int kc = sc * 2;               \
    *(bf16x8*)((char*)K_lds + (b) * SHM_K + KSWZ(sr, kc)) = sr_[i].ks0;                       \
    *(bf16x8*)((char*)K_lds + (b) * SHM_K + KSWZ(32 + sr, kc)) = sr_[i].ks1; } while (0)
#define SWAIT() do { if (SDEPTH == 2) asm volatile("s_waitcnt vmcnt(4)" ::: "memory"); else asm volatile("s_waitcnt vmcnt(0)" ::: "memory"); } while (0)
#define RESC(a) do { if (__any((a) < 1.f)) { if (hi == 0) al_l[r32] = (a); asm volatile("s_waitcnt lgkmcnt(0)" ::: "memory"); \
    _Pragma("unroll") for (int d = 0; d < 5; ++d) _Pragma("unroll") for (int r = 0; r < 16; ++r) o[d][r] *= al_l[crow(r, hi)]; } } while (0)
#define HOOK(P0, P1, i) do { \
    if (MODE == 1) { const int trel = mp + (i); \
      if (trel < cc || trel > cc + 8) { _Pragma("unroll") for (int r = 0; r < 16; ++r) { P0[r] = -__builtin_inff(); P1[r] = -__builtin_inff(); } } \
      else { const int base = 32 * wid + r32 + 512 - 64 * trel - 4 * hi; \
        if (32 * wid + 512 - 64 * trel - 63 >= 128) { const float cb = tbl[256]; _Pragma("unroll") for (int r = 0; r < 16; ++r) { P0[r] += cb; P1[r] += cb; } } \
        else { _Pragma("unroll") for (int r = 0; r < 16; ++r) { const int c_r = (r & 3) + 8 * (r >> 2); int i0 = base - c_r, i1 = base - c_r - 32; i0 = (i0 < 128 ? i0 : 128) + 128; i1 = (i1 < 128 ? i1 : 128) + 128; \
            P0[r] += tbl[i0]; P1[r] += tbl[i1]; } } } } \
    if (MODE == 2) { if ((i) > mp + cc) { asm volatile("" ::: "memory"); _Pragma("unroll") for (int r = 0; r < 16; ++r) { P0[r] = -__builtin_inff(); P1[r] = -__builtin_inff(); } } }     \
  } while (0)
#define MLOAD(W0, W1, i) do { if (MODE == 2) { const unsigned* mpz = mrow + (size_t)(i) * 16384; W0 = mpz[0] >> (2 * hi); W1 = mpz[1] >> (2 * hi); } } while (0)
  f32x16 pA0, pA1, pB0, pB1; float mnA, mnB, alA, alB; bf16x8 pa0, pa1, pa2, pa3; unsigned mA0 = 0, mA1 = 0, mB0 = 0, mB1 = 0;
  constexpr int SE = 0, SO = SDEPTH - 1;
  SLOAD(SE, 0); MLOAD(mA0, mA1, 0); asm volatile("s_waitcnt vmcnt(0)" ::: "memory"); SWRITE(0, SE); __syncthreads();
  qkt(pA0, pA1, K_lds, qr, r32, hi); HOOK(pA0, pA1, 0); partialSM(pA0, pA1, m_reg, mnA, alA);
  SLOAD(SO, KVBLK); if (SDEPTH == 2) { if (2 < NT) SLOAD(SE, 2 * KVBLK); }
  SWAIT(); SWRITE(1, SO); __syncthreads();
  for (int j = 1; j + 1 < NT; j += 2) {
    SBAR(); qkt(pB0, pB1, (bf16*)((char*)K_lds + SHM_K), qr, r32, hi); HOOK(pB0, pB1, j);
    finishSM<MODE>(pA0, pA1, pa0, pa1, pa2, pa3, mA0, mA1); SBAR();
    MLOAD(mB0, mB1, j); SLOAD(SO, (j + SDEPTH) * KVBLK); SBAR();
    pv_d0(o, vb0, pa0, pa1, pa2, pa3); partialSM(pB0, pB1, m_reg, mnB, alB);
    __syncthreads(); SWAIT(); SWRITE(0, SE);
    RESC(alB); __syncthreads();
    SBAR(); qkt(pA0, pA1, K_lds, qr, r32, hi); HOOK(pA0, pA1, j + 1);
    finishSM<MODE>(pB0, pB1, pa0, pa1, pa2, pa3, mB0, mB1); SBAR();
    MLOAD(mA0, mA1, j + 1); if (SDEPTH == 1 || j + 3 < NT) SLOAD(SE, (j + 1 + SDEPTH) * KVBLK); SBAR();
    pv_d0(o, vb0 + (int)SHM_V, pa0, pa1, pa2, pa3); partialSM(pA0, pA1, m_reg, mnA, alA);
    __syncthreads(); SWAIT(); SWRITE(1, SO);
    RESC(alA); __syncthreads();
  }
  SBAR(); qkt(pB0, pB1, (bf16*)((char*)K_lds + SHM_K), qr, r32, hi); HOOK(pB0, pB1, NT - 1);
  finishSM<MODE>(pA0, pA1, pa0, pa1, pa2, pa3, mA0, mA1); SBAR();
  MLOAD(mB0, mB1, NT - 1);
  pv_d0(o, vb0, pa0, pa1, pa2, pa3); partialSM(pB0, pB1, m_reg, mnB, alB);
  __syncthreads(); RESC(alB);
  finishSM<MODE>(pB0, pB1, pa0, pa1, pa2, pa3, mB0, mB1); SBAR();
  pv_d0(o, vb0 + (int)SHM_V, pa0, pa1, pa2, pa3);
  float rli[16];
#pragma unroll
  for (int r = 0; r < 16; ++r) rli[r] = __builtin_amdgcn_rcpf(o[4][r]);
  bf16* Ow = Ob + (long)(wid * QBLK) * LDO;
#pragma unroll
  for (int r = 0; r < 16; ++r) { int orow = crow(r, hi);
#pragma unroll
    for (int d0 = 0; d0 < 4; ++d0) Ow[(long)orow * LDO + d0 * 32 + r32] = (bf16)f2bf(o[d0][r] * rli[r]); }
#undef SLOAD
#undef SWRITE
#undef SWAIT
#undef RESC
#undef HOOK
#undef MLOAD
}
}

__device__ __forceinline__ unsigned fkey(float f) { const unsigned u = __float_as_uint(f); return u ^ ((u >> 31) ? 0xffffffffu : 0x80000000u); }
__device__ __forceinline__ float keyf(unsigned k) { return __uint_as_float((k & 0x80000000u) ? (k ^ 0x80000000u) : ~k); }
constexpr int IDX_CAP = 512, IDX_WAVE_BYTES = 4 * IDX_CAP * 8 + 1024;
static_assert(NWAVES * IDX_WAVE_BYTES <= RING_BYTES, "indexer LDS");

__device__ __forceinline__ unsigned idx_select(const LAS u32x2* buf, int m, int lane, unsigned (&uk)[8], unsigned (&ui)[8], int slack) {
    unsigned a = 0xffffffffu, o = 0u;
#pragma unroll
    for (int j = 0; j < 8; ++j) { const int e = lane + 64 * j; u32x2 v = {0u, 0u}; if (e < m) { v = buf[e]; a &= v.x; } uk[j] = v.x; ui[j] = v.y; o |= v.x; }
#pragma unroll
    for (int sh = 1; sh < 64; sh <<= 1) { a &= (unsigned)__shfl_xor((int)a, sh); o |= (unsigned)__shfl_xor((int)o, sh); }
    const unsigned diff = (unsigned)__builtin_amdgcn_readfirstlane((int)(a ^ o)); a = (unsigned)__builtin_amdgcn_readfirstlane((int)a);
    if (diff == 0u) return a;
    const int p = 31 - __builtin_clz(diff);
    unsigned T = a & ~((2u << p) - 1u);
    int cT = m;
    for (int bit = p; bit >= 0; --bit) { const unsigned Tt = T | (1u << bit); int c = 0;
#pragma unroll
        for (int j = 0; j < 8; ++j) c += __popcll(__ballot(uk[j] >= Tt));
        if (c >= 256) { T = Tt; cT = c; }
        if (cT <= slack + 256) break; }
    return T;
}
__device__ __forceinline__ void idx_keep(unsigned T, int lane, const unsigned (&uk)[8], bool (&keep)[8]) {
    int cgt = 0;
#pragma unroll
    for (int j = 0; j < 8; ++j) cgt += __popcll(__ballot(uk[j] > T));
    const int need = 256 - cgt; int eqb = 0;
#pragma unroll
    for (int j = 0; j < 8; ++j) { const bool eq = uk[j] == T; const unsigned long long mk = __ballot(eq);
        const int rank = eqb + __builtin_amdgcn_mbcnt_hi((unsigned)(mk >> 32), __builtin_amdgcn_mbcnt_lo((unsigned)mk, 0u));
        keep[j] = uk[j] > T || (eq && rank < need); eqb += __popcll(mk); }
}
__device__ __forceinline__ unsigned idx_prune(LAS u32x2* buf, int& n, int lane) {
    unsigned uk[8], ui[8]; bool keep[8];
    const unsigned T = idx_select(buf, n, lane, uk, ui, 48);
    idx_keep(T, lane, uk, keep);
    int nn = 0;
#pragma unroll
    for (int j = 0; j < 8; ++j) { const unsigned long long mk = __ballot(keep[j]);
        const int pos = nn + __builtin_amdgcn_mbcnt_hi((unsigned)(mk >> 32), __builtin_amdgcn_mbcnt_lo((unsigned)mk, 0u));
        if (keep[j]) buf[pos] = (u32x2){uk[j], ui[j]};
        nn += __popcll(mk); }
    LDS_WAIT();
    n = nn; return T;
}
__device__ __forceinline__ void idx_append(float sc, float tau, unsigned s, int g, int lane, LAS u32x2* blo, LAS u32x2* bhi, int& nlo, int& nhi) {
    const bool pass = sc > tau; const unsigned long long mk = __ballot(pass);
    const unsigned mlo = (unsigned)mk, mhi = (unsigned)(mk >> 32), mine = g ? mhi : mlo;
    const int pos = (g ? nhi : nlo) + __popc(mine & ((1u << (lane & 31)) - 1u));
    LAS u32x2* b = g ? bhi : blo;
    if (pass) b[pos] = (u32x2){fkey(sc), s};
    nlo += __popc(mlo); nhi += __popc(mhi);
}

__device__ __forceinline__ float idx_relu(float x) { const int b = __builtin_bit_cast(int, x); return __builtin_bit_cast(float, b > 0 ? b : 0); }
template <int PROBE>
__device__ __forceinline__ void indexer_phase(Frame& F, unsigned* maskw) {
    unsigned char* ws = F.ws;
    const bf16* qi = (const bf16*)(ws + WS_R1 + R1_QI); const bf16* ki = (const bf16*)(ws + WS_R1 + R1_KI); const float* wi = (const float*)(ws + WS_R1 + R1_WI);
    const int lane = F.lane, g = lane >> 5, hh = lane >> 5, rho = lane & 31;
    const int vcu = (F.G % 8 == 0) ? (F.bx % 8) * (F.G / 8) + F.bx / 8 : F.bx;
    const int gw = vcu * NWAVES + F.wave, NGW = F.G * NWAVES;
    LAS unsigned char* wl = F.lds + F.wave * IDX_WAVE_BYTES;
    LAS u32x2* B0 = (LAS u32x2*)wl; LAS u32x2* B1 = B0 + IDX_CAP; LAS u32x2* B2 = B1 + IDX_CAP; LAS u32x2* B3 = B2 + IDX_CAP;
    LAS unsigned* mrow = (LAS unsigned*)(wl + 4 * IDX_CAP * 8);
    const int a_tt = 2 * ((rho >> 2) & 1) + (rho >> 4), a_h = 4 * ((rho >> 3) & 1) + (rho & 3);
    for (int b = 0; b < NB; ++b)
    for (int uq0 = gw; uq0 < SEQ / 4; uq0 += NGW) {
        const int uq = (b & 1) ? (SEQ / 4 - 1 - uq0) : uq0;
        const int t0 = 4 * uq, chunk = t0 >> 6, n = 64 * (chunk + 1); const size_t rowbase = (size_t)b * SEQ + t0;
        if (n <= 256) {
            if (lane < 8 * (chunk + 1)) { const int T64 = lane >> 3, tt = (lane >> 1) & 3, w = lane & 1; maskw[(((size_t)b * 128 + T64) * SEQ + t0 + tt) * 2 + w] = 0xffffffffu; }
            continue; }
        bf16x8 qa[4];
#pragma unroll
        for (int s4 = 0; s4 < 4; ++s4) qa[s4] = *(const GAS bf16x8*)(qi + (rowbase + a_tt) * NIQ + a_h * 64 + hh * 32 + s4 * 8);
        const f32x8 wlo = *(const GAS f32x8*)(wi + (rowbase + 2 * g) * NIH), whi = *(const GAS f32x8*)(wi + (rowbase + 2 * g + 1) * NIH);
        int n0 = 0, n1 = 0, n2 = 0, n3 = 0; float tau0 = PROBE ? __builtin_inff() : -__builtin_inff(), tau1 = tau0;
        const bf16* kib = ki + (size_t)b * SEQ * NIK + (size_t)lane * 8;
        const int npair = n / 64;
        bf16x8 k0[8], k1[8], k2[8];
#define IDX_LOAD(K, pr) do { if (PROBE == 2 && (pr) >= 3) break; _Pragma("unroll") for (int s8 = 0; s8 < 8; ++s8) K[s8] = *(const GAS bf16x8*)(kib + ((size_t)(pr) * 2 + (s8 >> 2)) * 2048 + (s8 & 3) * 512); } while (0)
#define IDX_TILE(K, o, tile) do { f32x16 acc = {}; \
            _Pragma("unroll") for (int s4 = 0; s4 < 4; ++s4) acc = __builtin_amdgcn_mfma_f32_32x32x16_bf16(qa[s4], K[(o) + s4], acc, 0, 0, 0); \
            float sc0 = 0.f, sc1 = 0.f; \
            _Pragma("unroll") for (int i = 0; i < 8; ++i) { sc0 = fmaf(wlo[i], idx_relu(acc[i]), sc0); sc1 = fmaf(whi[i], idx_relu(acc[8 + i]), sc1); } \
            sc0 = (sc0 == 0.f) ? 0.f : sc0; sc1 = (sc1 == 0.f) ? 0.f : sc1; \
            const unsigned s = (unsigned)(32 * (tile) + rho); \
            idx_append(sc0, tau0, s, g, lane, B0, B2, n0, n2); \
            idx_append(sc1, tau1, s, g, lane, B1, B3, n1, n3); \
            if (max(max(n0, n1), max(n2, n3)) > IDX_CAP - 32) { LDS_WAIT(); \
                if (n0 > IDX_CAP - 32) { const unsigned T = idx_prune(B0, n0, lane); if (g == 0) tau0 = keyf(T); } \
                if (n2 > IDX_CAP - 32) { const unsigned T = idx_prune(B2, n2, lane); if (g == 1) tau0 = keyf(T); } \
                if (n1 > IDX_CAP - 32) { const unsigned T = idx_prune(B1, n1, lane); if (g == 0) tau1 = keyf(T); } \
                if (n3 > IDX_CAP - 32) { const unsigned T = idx_prune(B3, n3, lane); if (g == 1) tau1 = keyf(T); } } \
        } while (0)
        IDX_LOAD(k0, 0); if (1 < npair) IDX_LOAD(k1, 1); if (2 < npair) IDX_LOAD(k2, 2);
        for (int pr = 0; pr < npair; pr += 3) {
            IDX_TILE(k0, 0, 2 * pr); IDX_TILE(k0, 4, 2 * pr + 1); if (pr + 3 < npair) IDX_LOAD(k0, pr + 3);
            if (pr + 1 < npair) { IDX_TILE(k1, 0, 2 * pr + 2); IDX_TILE(k1, 4, 2 * pr + 3); if (pr + 4 < npair) IDX_LOAD(k1, pr + 4); }
            if (pr + 2 < npair) { IDX_TILE(k2, 0, 2 * pr + 4); IDX_TILE(k2, 4, 2 * pr + 5); if (pr + 5 < npair) IDX_LOAD(k2, pr + 5); }
        }
#undef IDX_LOAD
#undef IDX_TILE
        LDS_WAIT();
        if (PROBE) { if (lane == 0) maskw[rowbase] = (unsigned)(n0 + n1 + n2 + n3); continue; }
#pragma unroll
        for (int qq = 0; qq < 4; ++qq) {
            LAS u32x2* B = qq == 0 ? B0 : qq == 1 ? B1 : qq == 2 ? B2 : B3; const int m = qq == 0 ? n0 : qq == 1 ? n1 : qq == 2 ? n2 : n3;
            unsigned uk[8], ui[8]; bool keep[8]; const unsigned T = idx_select(B, m, lane, uk, ui, 0);
            idx_keep(T, lane, uk, keep);
#pragma unroll
            for (int j = 0; j < 4; ++j) mrow[lane + 64 * j] = 0u;
            LDS_WAIT();
#pragma unroll
            for (int j = 0; j < 8; ++j) { if (keep[j]) __hip_atomic_fetch_or(mrow + (ui[j] >> 5), 1u << (((ui[j] >> 1) & 15u) | ((ui[j] & 1u) << 4)), __ATOMIC_RELAXED, __HIP_MEMORY_SCOPE_WORKGROUP);     }
            LDS_WAIT();
            for (int T64 = lane; T64 <= chunk; T64 += 64) { const u32x2 wv = {mrow[2 * T64], mrow[2 * T64 + 1]};
                *(GAS u32x2*)(maskw + (((size_t)b * 128 + T64) * SEQ + t0 + qq) * 2) = wv; }
            LDS_WAIT();
        }
    }
}

__device__ __forceinline__ int block_sum_int(int v, LAS int* red, int wave, int lane, int& par) {
#pragma unroll
    for (int o = 1; o < 64; o <<= 1) v += __shfl_xor(v, o);
    LAS int* r = red + 8 * par; par ^= 1;
    if (lane == 0) r[wave] = v;
    __syncthreads();
    int s = 0;
#pragma unroll
    for (int w = 0; w < NWAVES; ++w) s += r[w];
    return s;
}
constexpr int SL_QF = 0, SL_QIF = 2048, SL_WIF = 2560, SL_RED = 2576, SL_SEL = 2592, SL_SELM = 2848, SL_SCO = 3008, SL_KP = SL_SCO + 12 * 528 + 4 * 256, SL_VP = SL_KP + 2 * 528, SL_END = SL_VP + 2 * 528;
static_assert(SL_END * 4 <= RING_BYTES, "sample LDS");
__device__ __forceinline__ void sample_task(Frame& F, int layer, int tok) {
    unsigned char* ws = F.ws; LAS float* L = (LAS float*)F.lds;
    const int tid = F.tid, lane = F.lane, wave = F.wave;
    const int sb = tok >> 4, st = tok & 15; const size_t row = (size_t)MP + tok;
    const bf16* qb = (const bf16*)(ws + WS_R1 + R1_Q) + row * NQ; const bf16* qmb = (const bf16*)(ws + WS_R1 + R1_QM) + row * NMQ;
    LAS float* qf = L + SL_QF; LAS float* qif = L + SL_QIF; LAS float* wif = L + SL_WIF; LAS int* red = (LAS int*)(L + SL_RED); LAS int* sel = (LAS int*)(L + SL_SEL);
    LAS unsigned* selm = (LAS unsigned*)(L + SL_SELM); LAS float* sco = L + SL_SCO;
    __syncthreads();
    for (int i = tid; i < 2048; i += 512) qf[i] = i < NQ ? bf2f(qb[i]) : bf2f(qmb[i - NQ]);
    if (layer == 0) { const bf16* qib = (const bf16*)(ws + WS_R1 + R1_QI) + row * NIQ; qif[tid] = bf2f(qib[tid]); if (tid < 8) wif[tid] = ((const float*)(ws + WS_R1 + R1_WI))[row * NIH + tid]; }
    if (tid < 160) selm[tid] = 0u;
    __syncthreads();
    const int nk = layer == 0 ? 256 : 528;
    if (layer == 0) {
        constexpr int LK = PAST + DS; unsigned uk[9];
#pragma unroll
        for (int j = 0; j < 9; ++j) { const int s = tid + 512 * j; uk[j] = 0u;
            if (s < LK) { const float* kr = s < PAST ? F.P->in[IN_CAI] + ((size_t)sb * PAST + s) * NIK : F.out + O_AIS + ((size_t)sb * DS + (s - PAST)) * NIK;
                float a0 = 0.f, a1 = 0.f, a2 = 0.f, a3 = 0.f, a4 = 0.f, a5 = 0.f, a6 = 0.f, a7 = 0.f;
                f32x4 tt[16];
#pragma unroll
                for (int d = 0; d < 16; ++d) tt[d] = *(const GAS f32x4*)(kr + 4 * d);
#pragma unroll
                for (int d = 0; d < 16; ++d) { const f32x4 t = tt[d]; const LAS float* qp = qif + 4 * d;
#define DOT4(A, H) A = fmaf(qp[(H) * 64 + 3], t[3], fmaf(qp[(H) * 64 + 2], t[2], fmaf(qp[(H) * 64 + 1], t[1], fmaf(qp[(H) * 64], t[0], A))))
                    DOT4(a0, 0); DOT4(a1, 1); DOT4(a2, 2); DOT4(a3, 3); DOT4(a4, 4); DOT4(a5, 5); DOT4(a6, 6); DOT4(a7, 7);
#undef DOT4
                }
                float sc = wif[0] * fmaxf(a0, 0.f); sc = fmaf(wif[1], fmaxf(a1, 0.f), sc); sc = fmaf(wif[2], fmaxf(a2, 0.f), sc); sc = fmaf(wif[3], fmaxf(a3, 0.f), sc);
                sc = fmaf(wif[4], fmaxf(a4, 0.f), sc); sc = fmaf(wif[5], fmaxf(a5, 0.f), sc); sc = fmaf(wif[6], fmaxf(a6, 0.f), sc); sc = fmaf(wif[7], fmaxf(a7, 0.f), sc);
                sc = (sc == 0.f) ? 0.f : sc; uk[j] = fkey(sc); } }
        unsigned T = 0; int par = 0;
        for (int bit = 31; bit >= 0; --bit) { const unsigned Tt = T | (1u << bit); int c = 0;
#pragma unroll
            for (int j = 0; j < 9; ++j) c += (uk[j] >= Tt) ? 1 : 0;
            if (block_sum_int(c, red, wave, lane, par) >= 256) T = Tt; }
        int cg = 0, ce = 0;
#pragma unroll
        for (int j = 0; j < 9; ++j) { cg += (uk[j] > T) ? 1 : 0; ce += (uk[j] == T) ? 1 : 0; }
        const int cgt = block_sum_int(cg, red, wave, lane, par), ceq = block_sum_int(ce, red, wave, lane, par), need = 256 - cgt;
        unsigned X = 0xffffffffu;
        if (need < ceq) { X = 0;
            for (int bit = 12; bit >= 0; --bit) { const unsigned Xt = X | (1u << bit); int c = 0;
#pragma unroll
                for (int j = 0; j < 9; ++j) c += (uk[j] == T && (unsigned)(tid + 512 * j) < Xt) ? 1 : 0;
                if (block_sum_int(c, red, wave, lane, par) < need) X = Xt; } }
#pragma unroll
        for (int j = 0; j < 9; ++j) { const unsigned s = (unsigned)(tid + 512 * j); if (uk[j] > T || (uk[j] == T && uk[j] != 0u && s <= X)) __hip_atomic_fetch_or(selm + (s >> 5), 1u << (s & 31u), __ATOMIC_RELAXED, __HIP_MEMORY_SCOPE_WORKGROUP); }
        __syncthreads();
        if (tid < 129) { int pos = 0; for (int w = 0; w < tid; ++w) pos += __popc(selm[w]); unsigned mw = selm[tid]; while (mw) { const int bpos = __builtin_ctz(mw); mw &= mw - 1u; if (pos < 256) sel[pos] = 32 * tid + bpos; ++pos; } }
        __syncthreads();
    }
    LAS unsigned long long* kpt = (LAS unsigned long long*)(L + SL_KP); LAS unsigned long long* vpt = (LAS unsigned long long*)(L + SL_VP);
    for (int jx = tid; jx < nk; jx += 512) { const float *kr, *vr;
        if (layer == 0) { const int s = sel[jx];
            if (s < PAST) { kr = F.P->in[IN_CAK] + ((size_t)sb * PAST + s) * 512; vr = F.P->in[IN_CAV] + ((size_t)sb * PAST + s) * 512; }
            else { kr = F.out + O_AKS + ((size_t)sb * DS + (s - PAST)) * 512; vr = F.out + O_AVS + ((size_t)sb * DS + (s - PAST)) * 512; } }
        else { if (jx < BBUF) { kr = F.P->in[IN_CBK] + ((size_t)sb * BBUF + jx) * 512; vr = F.P->in[IN_CBV] + ((size_t)sb * BBUF + jx) * 512; }
            else { kr = F.out + O_BKS + ((size_t)sb * BBUF + (BBUF - DS) + (jx - BBUF)) * 512; vr = F.out + O_BVS + ((size_t)sb * BBUF + (BBUF - DS) + (jx - BBUF)) * 512; } }
        kpt[jx] = (unsigned long long)(uintptr_t)kr; vpt[jx] = (unsigned long long)(uintptr_t)vr; }
    __syncthreads();
    const int ntok = 12 * nk, ngk = 4 * nk, ntot = ngk + 4 * NMEM;
    for (int p = tid; p < ntot; p += 512) {
        const float* kr; int h, jx;
        if (p < ngk) { const int gk = p / nk; jx = p - gk * nk; h = 3 * gk; kr = (const float*)(uintptr_t)kpt[jx] + gk * 128; }
        else { const int pm = p - ngk; h = 12 + (pm >> 8); jx = pm & 255; kr = F.P->in[IN_CMK] + ((((size_t)layer * DB + sb) * NMEM + jx) * 4 + (h - 12)) * 128; }
        f32x4 tr[32];
#pragma unroll
        for (int d = 0; d < 32; ++d) tr[d] = *(const GAS f32x4*)(kr + 4 * d);
        if (h < 12) { float a0 = 0.f, a1 = 0.f, a2 = 0.f;
#pragma unroll
            for (int d = 0; d < 32; ++d) { const f32x4 t = tr[d]; const LAS float* q0 = qf + h * 128 + 4 * d;
                a0 = fmaf(q0[0], t[0], a0); a0 = fmaf(q0[1], t[1], a0); a0 = fmaf(q0[2], t[2], a0); a0 = fmaf(q0[3], t[3], a0);
                a1 = fmaf(q0[128], t[0], a1); a1 = fmaf(q0[129], t[1], a1); a1 = fmaf(q0[130], t[2], a1); a1 = fmaf(q0[131], t[3], a1);
                a2 = fmaf(q0[256], t[0], a2); a2 = fmaf(q0[257], t[1], a2); a2 = fmaf(q0[258], t[2], a2); a2 = fmaf(q0[259], t[3], a2); }
            float b0 = 0.f, b1 = 0.f, b2 = 0.f;
            if (layer == 1) { const int kp = jx < BBUF ? PAST - BBUF + jx : PAST + (jx - BBUF); int rel = (PAST + st) - kp; rel = rel < -128 ? -128 : (rel > 128 ? 128 : rel);
                const float* rb = F.P->in[IN_RELB] + h * 257 + rel + 128; b0 = rb[0]; b1 = rb[257]; b2 = rb[514]; }
            sco[h * nk + jx] = a0 * ATT_SCALE + b0; sco[(h + 1) * nk + jx] = a1 * ATT_SCALE + b1; sco[(h + 2) * nk + jx] = a2 * ATT_SCALE + b2; }
        else { float a = 0.f;
#pragma unroll
            for (int d = 0; d < 32; ++d) { const f32x4 t = tr[d]; const LAS float* q0 = qf + h * 128 + 4 * d; a = fmaf(q0[0], t[0], a); a = fmaf(q0[1], t[1], a); a = fmaf(q0[2], t[2], a); a = fmaf(q0[3], t[3], a); }
            sco[ntok + (h - 12) * NMEM + jx] = a * ATT_SCALE; }
    }
    __syncthreads();
    for (int h = wave; h < 16; h += NWAVES) { const int cnt = h < 12 ? nk : NMEM; LAS float* sp = sco + (h < 12 ? h * nk : ntok + (h - 12) * NMEM);
        float mx = -__builtin_inff(); for (int i = lane; i < cnt; i += 64) mx = fmaxf(mx, sp[i]); mx = wave_max(mx);
        float sm = 0.f; for (int i = lane; i < cnt; i += 64) { const float e = __expf(sp[i] - mx); sp[i] = e; sm += e; } sm = wave_sum(sm);
        const float inv = 1.f / sm; for (int i = lane; i < cnt; i += 64) sp[i] *= inv; }
    __syncthreads();
    bf16* ao = (bf16*)(ws + WS_R1 + R1_AO) + row * DM;
    { const int grp = tid >> 5, d4 = (tid & 31) * 4, slice = grp & 1; f32x4 a0 = {0.f, 0.f, 0.f, 0.f}, a1 = a0, a2 = a0;
      const int hb = grp < 8 ? 3 * (grp >> 1) : 12 + ((grp - 8) >> 1);
      if (grp < 8) { const int gk = grp >> 1; const LAS float* sp = sco + hb * nk;
#pragma unroll 1
          for (int j0 = 16 * slice; j0 < nk; j0 += 32) { f32x4 vv[16];
#pragma unroll
              for (int u = 0; u < 16; ++u) vv[u] = *(const GAS f32x4*)((const float*)(uintptr_t)vpt[j0 + u] + gk * 128 + d4);
#pragma unroll
              for (int u = 0; u < 16; ++u) { a0 += vv[u] * sp[j0 + u]; a1 += vv[u] * sp[nk + j0 + u]; a2 += vv[u] * sp[2 * nk + j0 + u]; } } }
      else { const LAS float* sp = sco + ntok + (hb - 12) * NMEM; const float* vb = F.P->in[IN_CMV] + ((((size_t)layer * DB + sb) * NMEM) * 4 + (hb - 12)) * 128 + d4;
#pragma unroll 1
          for (int j0 = 16 * slice; j0 < NMEM; j0 += 32) { f32x4 vv[16];
#pragma unroll
              for (int u = 0; u < 16; ++u) vv[u] = *(const GAS f32x4*)(vb + (size_t)(j0 + u) * 512);
#pragma unroll
              for (int u = 0; u < 16; ++u) a0 += vv[u] * sp[j0 + u]; } }
      LAS float* part = qf + hb * 128 + d4;
      if (slice) { *(LAS f32x4*)part = a0; if (grp < 8) { *(LAS f32x4*)(part + 128) = a1; *(LAS f32x4*)(part + 256) = a2; } }
      __syncthreads();
      if (!slice) { a0 += *(const LAS f32x4*)part; u32x2 o; o.x = pk2(a0[0], a0[1]); o.y = pk2(a0[2], a0[3]); *(GAS u32x2*)(ao + hb * 128 + d4) = o;
          if (grp < 8) { a1 += *(const LAS f32x4*)(part + 128); a2 += *(const LAS f32x4*)(part + 256);
              o.x = pk2(a1[0], a1[1]); o.y = pk2(a1[2], a1[3]); *(GAS u32x2*)(ao + (hb + 1) * 128 + d4) = o;
              o.x = pk2(a2[0], a2[1]); o.y = pk2(a2[2], a2[3]); *(GAS u32x2*)(ao + (hb + 2) * 128 + d4) = o; } } }
    __syncthreads();
}

#ifdef DBG_CHECK
__device__ __forceinline__ void dbg_token_task(Frame& F, int layer, int b, int t, float* acc) {
    int dpar_ = 0;
    unsigned char* ws = F.ws; LAS float* L = (LAS float*)F.lds;
    const int tid = F.tid, lane = F.lane, wave = F.wave;
    const size_t row = (size_t)b * SEQ + t; const size_t brow = (size_t)b * SEQ;
    const bf16* qb = (const bf16*)(ws + WS_R1 + R1_Q) + row * NQ; const bf16* qmb = (const bf16*)(ws + WS_R1 + R1_QM) + row * NMQ;
    const bf16* kbuf = (const bf16*)(ws + WS_R1 + R1_K); const bf16* vbuf = (const bf16*)(ws + WS_R1 + R1_V); const bf16* kibuf = (const bf16*)(ws + WS_R1 + R1_KI);
    const bf16* mkb = (const bf16*)(ws + WS_MKB) + ((size_t)layer * 1024 + (size_t)b * NMEM) * 512; const bf16* mvb = (const bf16*)(ws + WS_MVB) + ((size_t)layer * 1024 + (size_t)b * NMEM) * 512;
    LAS float* qf = L + SL_QF; LAS float* qif = L + SL_QIF; LAS float* wif = L + SL_WIF; LAS int* red = (LAS int*)(L + SL_RED); LAS int* sel = (LAS int*)(L + SL_SEL);
    LAS unsigned* selm = (LAS unsigned*)(L + 16384); LAS float* sco = L + SL_SCO;
    __syncthreads();
    for (int i = tid; i < 2048; i += 512) qf[i] = i < NQ ? bf2f(qb[i]) : bf2f(qmb[i - NQ]);
    if (layer == 0) { const bf16* qib = (const bf16*)(ws + WS_R1 + R1_QI) + row * NIQ; qif[tid] = bf2f(qib[tid]); if (tid < 8) wif[tid] = ((const float*)(ws + WS_R1 + R1_WI))[row * NIH + tid]; }
    if (tid < 256) selm[tid] = 0u;
    __syncthreads();
    const int chunk = t >> 6;
    int nk, key0 = 0;
    if (layer == 0) {
        const int n = 64 * (chunk + 1);
        LAS unsigned* ukl = (LAS unsigned*)(L + 20000);
#pragma unroll 1
        for (int s = tid; s < n; s += 512) { float sc = 0.f;
#pragma unroll 1
            for (int h = 0; h < 8; ++h) { float a = 0.f;
#pragma unroll 4
                for (int d = 0; d < 64; ++d) a = fmaf(qif[h * 64 + d], bf2f(kibuf[ki_tiled(brow + s, d)]), a);
                sc = fmaf(wif[h], fmaxf(a, 0.f), sc); }
            sc = (sc == 0.f) ? 0.f : sc; ukl[s] = fkey(sc); }
        __syncthreads();
        if (n <= 256) {
#pragma unroll 1
            for (int s = tid; s < n; s += 512) __hip_atomic_fetch_or(selm + (s >> 5), 1u << (s & 31), __ATOMIC_RELAXED, __HIP_MEMORY_SCOPE_WORKGROUP);
            nk = n;
        } else {
            unsigned T = 0;
#pragma unroll 1
            for (int bit = 31; bit >= 0; --bit) { const unsigned Tt = T | (1u << bit); int c = 0;
#pragma unroll 1
                for (int s = tid; s < n; s += 512) c += (ukl[s] >= Tt) ? 1 : 0;
                if (block_sum_int(c, red, wave, lane, dpar_) >= 256) T = Tt; }
            int cg = 0, ce = 0;
#pragma unroll 1
            for (int s = tid; s < n; s += 512) { cg += (ukl[s] > T) ? 1 : 0; ce += (ukl[s] == T) ? 1 : 0; }
            const int cgt = block_sum_int(cg, red, wave, lane, dpar_), ceq = block_sum_int(ce, red, wave, lane, dpar_), need = 256 - cgt;
            unsigned X = 0xffffffffu;
            if (need < ceq) { X = 0;
#pragma unroll 1
                for (int bit = 12; bit >= 0; --bit) { const unsigned Xt = X | (1u << bit); int c = 0;
#pragma unroll 1
                    for (int s = tid; s < n; s += 512) c += (ukl[s] == T && (unsigned)s < Xt) ? 1 : 0;
                    if (block_sum_int(c, red, wave, lane, dpar_) < need) X = Xt; } }
#pragma unroll 1
            for (int s = tid; s < n; s += 512) { const unsigned u = ukl[s]; if (u > T || (u == T && (unsigned)s <= X)) __hip_atomic_fetch_or(selm + (s >> 5), 1u << (s & 31), __ATOMIC_RELAXED, __HIP_MEMORY_SCOPE_WORKGROUP); }
            nk = 256;
        }
        __syncthreads();
        if (tid < 256) { int pos = 0; for (int w = 0; w < tid; ++w) pos += __popc(selm[w]); unsigned mw = selm[tid]; while (mw) { const int bpos = __builtin_ctz(mw); mw &= mw - 1u; if (pos < 256) sel[pos] = 32 * tid + bpos; ++pos; } }
        __syncthreads();
    } else { key0 = 64 * chunk - 512; if (key0 < 0) key0 = 0; nk = 64 * chunk + 64 - key0; }
    const int ntok = 12 * nk, ntot = ntok + 4 * NMEM;
    for (int p = tid; p < ntot; p += 512) {
        const bf16* kr; int h; float bias = 0.f;
        if (p < ntok) { h = p / nk; const int jx = p - h * nk, gk = h / 3; const int s = layer == 0 ? sel[jx] : key0 + jx; kr = kbuf + (brow + s) * NKV + gk * 128;
            if (layer == 1) { int rel = t - s; rel = rel < -128 ? -128 : (rel > 128 ? 128 : rel); bias = F.P->in[IN_RELB][h * 257 + rel + 128]; } }
        else { const int pm = p - ntok; h = 12 + (pm >> 8); kr = mkb + (size_t)(pm & 255) * 512 + (h - 12) * 128; }
        float a = 0.f; for (int d = 0; d < 128; ++d) a = fmaf(qf[h * 128 + d], bf2f(kr[d]), a);
        sco[p] = a * ATT_SCALE + bias;
    }
    __syncthreads();
    for (int h = wave; h < 16; h += NWAVES) { const int cnt = h < 12 ? nk : NMEM; LAS float* sp = sco + (h < 12 ? h * nk : ntok + (h - 12) * NMEM);
        float mx = -__builtin_inff(); for (int i = lane; i < cnt; i += 64) mx = fmaxf(mx, sp[i]); mx = wave_max(mx);
        float sm = 0.f; for (int i = lane; i < cnt; i += 64) { const float e = __expf(sp[i] - mx); sp[i] = e; sm += e; } sm = wave_sum(sm);
        const float inv = 1.f / sm; for (int i = lane; i < cnt; i += 64) sp[i] *= inv; }
    __syncthreads();
    const bf16* ao = (const bf16*)(ws + WS_R1 + R1_AO) + row * DM;
    float d2t = 0.f, r2t = 0.f, d2m = 0.f, r2m = 0.f;
#pragma unroll 1
    for (int i = 0; i < 4; ++i) { const int idx = tid + 512 * i, h = idx >> 7, d = idx & 127; float a = 0.f;
        if (h < 12) { const int gk = h / 3; const LAS float* sp = sco + h * nk;
            for (int jx = 0; jx < nk; ++jx) { const int s = layer == 0 ? sel[jx] : key0 + jx; a = fmaf(sp[jx], bf2f(vbuf[(brow + s) * NKV + gk * 128 + d]), a); } }
        else { const LAS float* sp = sco + ntok + (h - 12) * NMEM; for (int jx = 0; jx < NMEM; ++jx) a = fmaf(sp[jx], bf2f(mvb[(size_t)jx * 512 + (h - 12) * 128 + d]), a); }
        const float got = bf2f(ao[idx]), df = got - a;
        if (h < 12) { d2t += df * df; r2t += a * a; } else { d2m += df * df; r2m += a * a; } }
    d2t = wave_sum(d2t); r2t = wave_sum(r2t); d2m = wave_sum(d2m); r2m = wave_sum(r2m);
    if (lane == 0) { atomicAdd(acc + 0, d2t); atomicAdd(acc + 1, r2t); atomicAdd(acc + 2, d2m); atomicAdd(acc + 3, r2m); }
    __syncthreads();
}
#endif

#ifndef REPEAT_MASK
#define REPEAT_MASK 0
#endif
#define NREP(bit) ((REPEAT_MASK >> (bit)) & 1 ? 2 : 1)
#ifndef ATT_SD
#define ATT_SD 1
#endif
__device__ __forceinline__ int vcu_of(const Frame& F) { return (F.G % 8 == 0) ? (F.bx % 8) * (F.G / 8) + F.bx / 8 : F.bx; }
__device__ __forceinline__ void mem_units(Frame& F, int layer) {
    unsigned char* ws = F.ws; char* lds = (char*)F.lds;
    const bf16* qm = (const bf16*)(ws + WS_R1 + R1_QM); bf16* ao = (bf16*)(ws + WS_R1 + R1_AO);
    const bf16* mkb = (const bf16*)(ws + WS_MKB) + (size_t)layer * 1024 * 512; const bf16* mvb = (const bf16*)(ws + WS_MVB) + (size_t)layer * 1024 * 512;
    if (F.bx < F.G / 2) return;
    for (int u = F.bx - F.G / 2; u < NB * 4 * 32; u += F.G - F.G / 2) {
        const int j = u & 31, hm = (u >> 5) & 3, b = u >> 7; const size_t row0 = (size_t)b * SEQ + 256 * j;
        att::attn_unit<0, NMQ, ATT_SD>(qm + row0 * NMQ + hm * 128, mkb + (size_t)b * NMEM * 512 + hm * 128, mvb + (size_t)b * NMEM * 512 + hm * 128, ao + row0 * DM + NQ + hm * 128, NMEM / 64, 0, nullptr, lds);
    }
}
template <int MODE>
__device__ __forceinline__ void dsa_units(Frame& F, bf16* ao) {
    unsigned char* ws = F.ws; char* lds = (char*)F.lds;
    const bf16* q = (const bf16*)(ws + WS_R1 + R1_Q); const bf16* k = (const bf16*)(ws + WS_R1 + R1_K); const bf16* v = (const bf16*)(ws + WS_R1 + R1_V);
    const unsigned* maskw = (const unsigned*)(ws + WS_MASK);
    for (int p = vcu_of(F); p < NB * 12 * 16; p += F.G) {
        const int s = p & 15, bh = p >> 4, h3 = bh % 3, bg = bh / 3, gk = bg & 3, b = bg >> 2, h = gk * 3 + h3;
#pragma unroll 1
        for (int half = 0; half < 2; ++half) { const int j = half ? 31 - s : s; const size_t row0 = (size_t)b * SEQ + 256 * j;
            const unsigned* mrow = maskw + (((size_t)b * 128) * SEQ + 256 * j) * 2;
            att::attn_unit<MODE, NQ, ATT_SD>(q + row0 * NQ + h * 128, k + (size_t)b * SEQ * NKV + gk * 128, v + (size_t)b * SEQ * NKV + gk * 128, ao + row0 * DM + h * 128, 4 * (j + 1), 4 * j, mrow, lds); }
    }
}
__device__ __forceinline__ void attn_phase_A(Frame& F) {
    for (int rep_ = 0; rep_ < NREP(5); ++rep_) if (F.bx < MS) sample_task(F, 0, F.bx);
    dsa_units<2>(F, (bf16*)(F.ws + WS_R1 + R1_AO));
    mem_units(F, 0);
}
__device__ __forceinline__ void attn_phase_B(Frame& F) {
    unsigned char* ws = F.ws; char* lds = (char*)F.lds;
    for (int rep_ = 0; rep_ < NREP(5); ++rep_) if (F.bx < MS) sample_task(F, 1, F.bx);
    const bf16* q = (const bf16*)(ws + WS_R1 + R1_Q); const bf16* k = (const bf16*)(ws + WS_R1 + R1_K); const bf16* v = (const bf16*)(ws + WS_R1 + R1_V); bf16* ao = (bf16*)(ws + WS_R1 + R1_AO);
    float* tbl = (float*)(lds + att::SHM_TBL);
    for (int u = vcu_of(F); u < NB * 12 * 32; u += F.G) {
        const int j = u & 31, bh = u >> 5, h3 = bh % 3, bg = bh / 3, gk = bg & 3, b = bg >> 2, h = gk * 3 + h3;
        const int t0 = j >= 2 ? 0 : 8 - 4 * j;
        const size_t row0 = (size_t)b * SEQ + 256 * j; const long key0 = (long)256 * j - 512 + 64 * t0;
        __syncthreads();
        if (F.tid < 257) tbl[F.tid] = F.P->in[IN_RELB][h * 257 + F.tid] * (1.0f / ATT_SCALE);
        __syncthreads();
        att::attn_unit<1, NQ, ATT_SD>(q + row0 * NQ + h * 128, k + ((size_t)b * SEQ + key0) * NKV + gk * 128, v + ((size_t)b * SEQ + key0) * NKV + gk * 128, ao + row0 * DM + h * 128, 12 - t0, t0, nullptr, lds);
    }
    mem_units(F, 1);
}


#ifndef SK_SW_RB
#define SK_SW_RB 8
#endif
__device__ __forceinline__ void sk_swiglu(Frame& F, const bf16* Wt, const float* st, const float* cb, int ln) { unsigned char* ws = F.ws;
    for (int wg = F.bx; wg < 256; wg += F.G) { SkMapSwiglu rm{22 * wg}; SkEpiSwiglu ep{(bf16*)(ws + WS_R1), 22 * wg, st, cb, ln};
        skinny_gemm<4, SK_SW_RB, 8 / SK_SW_RB>((const bf16*)(ws + WS_X) + (size_t)MP * DM, DM, Wt, DM, rm, ep, (LAS float*)F.lds, wg, 0); } }
__device__ __forceinline__ void sk_resid(Frame& F, const bf16* A, int K, const bf16* Wt, float cs, const float* sto, const float* g, const float* b, float* stn, int ln) { unsigned char* ws = F.ws;
    for (int wg = F.bx; wg < 256; wg += F.G) { const int mi = wg & 3, ni = wg >> 2; SkMapLinear2 rm{32 * ni}; SkEpiResid ep{(bf16*)(ws + WS_X), 32 * ni, cs, ALPHA, sto, g, b, stn, ln};
        skinny_gemm<2, 2, 1>(A, K, Wt, K, rm, ep, (LAS float*)F.lds, wg, 32 * mi); } }
__device__ __forceinline__ void sk_inb(Frame& F, const float* st, const float* cb) { unsigned char* ws = F.ws;
    for (int wg = F.bx; wg < 256; wg += F.G) { SkMapLinear rm{12 * wg, 12}; SkEpiInB ep{ws, F.out, 12 * wg, st, cb};
        skinny_gemm<1, 8, 1>((const bf16*)(ws + WS_X) + (size_t)MP * DM, DM, (const bf16*)(ws + WS_WINB), DM, rm, ep, (LAS float*)F.lds, wg, 0); } }
__device__ __forceinline__ void sk_ina(Frame& F, const float* st, const float* cb) { unsigned char* ws = F.ws;
    for (int wg = F.bx; wg < 256; wg += F.G) { SkMapInA rm{wg}; SkEpiInA ep{ws, F.out, wg, st, cb};
        skinny_gemm<2, 8, 1>((const bf16*)(ws + WS_X) + (size_t)MP * DM, DM, (const bf16*)(ws + WS_WINA), DM, rm, ep, (LAS float*)F.lds, wg, 0); } }

#define PG8_SP2 true
#define PG8_ALIGN true
enum { PH_PRO = 0, PH_MEM, PH_L0, PH_PER_LAYER = 11, PH_END = PH_L0 + 2 * PH_PER_LAYER };

__global__ void __launch_bounds__(NWAVES * 64, 2) fwd_kernel(Params args) {
    extern __shared__ __attribute__((aligned(16))) unsigned char lds[];
    Frame F;
    F.lds = (LAS unsigned char*)lds;
    F.tid = threadIdx.x; F.lane = F.tid & 63; F.wave = __builtin_amdgcn_readfirstlane(F.tid >> 6);
    F.G = gridDim.x; F.bx = blockIdx.x;
    F.P = &args;
    F.out = args.out; F.ws = args.ws;
    for (int u = F.tid; u < (LDS_BYTES - LDSCTL_OFF) / 4; u += NWAVES * 64) ((LAS unsigned*)(F.lds + LDSCTL_OFF))[u] = 0u;
    __syncthreads();
    volatile LAS unsigned* MISC = (volatile LAS unsigned*)(F.lds + MISC_OFF);
    (void)xcd_barrier_post((unsigned*)(args.ws + WS_CTL) + CW_BAR, MISC + 8);
#ifdef MK_CUTS
    const int lo = args.ph_lo, hi = args.ph_hi;
#else
    constexpr int lo = 0, hi = PH_END;
#endif
#define IN(k) (lo <= (k) && (k) < hi)
#define SEAM(k) do { if (IN((k) + 1)) { XcdBarrier bb_; GAS unsigned* bw_ = (GAS unsigned*)(args.ws + WS_CTL) + CW_BAR; asm volatile("" : "+s"(bw_)); bb_.bar = (unsigned*)bw_; bb_.x = xb_xcc_id(); bb_.st = MISC + 8; xcd_barrier(bb_); } } while (0)
    PG8_LAS unsigned char* glds = (PG8_LAS unsigned char*)lds;
#define PHASE_BEGIN() { int t_ = threadIdx.x; asm volatile("" : "+v"(t_)); F.tid = t_; F.lane = t_ & 63; F.wave = __builtin_amdgcn_readfirstlane(t_ >> 6); int b_ = blockIdx.x, g_ = gridDim.x; asm volatile("" : "+s"(b_), "+s"(g_)); F.bx = b_; F.G = g_; } GAS unsigned char* wsg_ = (GAS unsigned char*)args.ws; asm volatile("" : "+s"(wsg_)); unsigned char* ws = (unsigned char*)wsg_; F.ws = ws; GAS float* og_ = (GAS float*)args.out; asm volatile("" : "+s"(og_)); F.out = (float*)og_;     bf16* X = (bf16*)(ws + WS_X); bf16* H = (bf16*)(ws + WS_R1); (void)X; (void)H

    for (int rep_ = 0; rep_ < NREP(0); ++rep_) if (IN(PH_PRO)) { PHASE_BEGIN(); p0_prologue(F); SEAM(PH_PRO); }
#pragma unroll 1
    for (int l = 0; l < 2; ++l) {
        const int P = PH_L0 + l * PH_PER_LAYER;
#define ST(i) ((float*)(ws + WS_STATS) + (size_t)(i) * MPAD * 2)
#define CB(m) ((const float*)(ws + CTL_CSBW) + (size_t)(m) * CSBW_STRIDE)
#define LG(i) (F.P->in[IN_LNG] + (size_t)(i) * DM)
#define LB(i) (F.P->in[IN_LNB] + (size_t)(i) * DM)
        for (int rep_ = 0; rep_ < (l == 0 ? NREP(4) : 1); ++rep_) if (IN(P + 0)) { PHASE_BEGIN(); const bf16* W = (const bf16*)(ws + WS_WFI + (size_t)(2 * l) * 44 * MiB);
            const float* st = ST(2); const float* cb = CB(FM_F1L1);
            pg8::Gemm g{X, W, MP, NFF2, DM}; pg8::StaticOrder S; S.init(MP, NFF2, F.G, F.bx); if (l) stats_finalize_local(F, S, (const float*)(ws + WS_STATP), ST(2)); sk_swiglu(F, W, st, cb, l);
            pg8::EpiSwiglu E{H, st, cb, l}; pg8::gemm_phase<pg8::EpiSwiglu, pg8::StaticOrder, PG8_ALIGN, PG8_SP2>(glds, g, S, E); SEAM(P + 0); }
        if (IN(P + 1)) { PHASE_BEGIN(); const bf16* W = (const bf16*)(ws + WS_WFO + (size_t)(2 * l) * 22 * MiB);
            const float* sto = ST(2); float* stn = ST(3 * l);
            sk_resid(F, H + (size_t)MP * DFF, DFF, W, 0.5f, sto, LG(2), LB(2), stn, l); pg8::Gemm g{H, W, MP, DM, DFF}; pg8::StaticOrder S; S.init(MP, DM, F.G, F.bx);
            pg8::EpiResid E{X, 0.5f, ALPHA, sto, LG(2), LB(2), (float*)(ws + WS_STATP), l}; pg8::gemm_phase<pg8::EpiResid, pg8::StaticOrder, PG8_ALIGN, PG8_SP2>(glds, g, S, E); SEAM(P + 1); }
        if (l == 0) {
            if (IN(P + 3)) { PHASE_BEGIN(); pg8::Gemm g{X, (const bf16*)(ws + WS_WINA), MP, PROJ_A_PAD, DM}; pg8::StaticOrder S; S.init(MP, PROJ_A_PAD, F.G, F.bx); stats_finalize_local(F, S, (const float*)(ws + WS_STATP), ST(0)); sk_ina(F, ST(0), CB(FM_INA));
                pg8::EpiInA E{ws, F.out, ST(0), CB(FM_INA)};
                pg8::gemm_phase<pg8::EpiInA, pg8::StaticOrder, PG8_ALIGN, PG8_SP2>(glds, g, S, E);
                {
                  pg8::Gemm g2{(const bf16*)(ws + WS_MEMB), (const bf16*)(ws + WS_WMEM), NB * NMEM, 2048, DM}; pg8::StaticOrder S2; S2.init(NB * NMEM, 2048, F.G, (F.bx + F.G / 2) % F.G);
                  pg8::EpiMem E2{F.out + O_MK, F.out + O_MV, (bf16*)(ws + WS_MKB), (bf16*)(ws + WS_MVB)};
                  pg8::gemm_phase<pg8::EpiMem, pg8::StaticOrder, PG8_ALIGN, PG8_SP2>(glds, g2, S2, E2); }
                SEAM(P + 3); }
            for (int rep_ = 0; rep_ < NREP(1); ++rep_) if (IN(P + 4)) { PHASE_BEGIN(); indexer_phase<0>(F, (unsigned*)(ws + WS_MASK)); SEAM(P + 4); }
            for (int rep_ = 0; rep_ < NREP(2); ++rep_) if (IN(P + 5)) { PHASE_BEGIN(); attn_phase_A(F); SEAM(P + 5); }
#ifdef SHADOW
            if (IN(P + 5)) { PHASE_BEGIN();
#if SHADOW == 1
                dsa_units<2>(F, (bf16*)(F.out + O_YP));
#elif SHADOW == 2
                dsa_units<0>(F, (bf16*)(F.out + O_YP));
#elif SHADOW == 4
                indexer_phase<1>(F, (unsigned*)(F.out + O_YP));
#elif SHADOW == 5
                indexer_phase<2>(F, (unsigned*)(F.out + O_YP));
#endif
                SEAM(P + 5); }
#endif
        } else {
            if (IN(P + 3)) { PHASE_BEGIN(); pg8::Gemm g{X, (const bf16*)(ws + WS_WINB), MP, PROJ_B, DM}; pg8::StaticOrder S; S.init(MP, PROJ_B, F.G, F.bx); stats_finalize_local(F, S, (const float*)(ws + WS_STATP), ST(3)); sk_inb(F, ST(3), CB(FM_INB));
                pg8::EpiInB E{ws, F.out, ST(3), CB(FM_INB)};
                pg8::gemm_phase<pg8::EpiInB, pg8::StaticOrder, PG8_ALIGN, PG8_SP2>(glds, g, S, E); SEAM(P + 3); }
            for (int rep_ = 0; rep_ < NREP(3); ++rep_) if (IN(P + 5)) { PHASE_BEGIN(); attn_phase_B(F); SEAM(P + 5); }
        }
#ifdef DBG_CHECK
        if (IN(P + 6)) { PHASE_BEGIN(); if (F.bx < 256) { const int b_ = F.bx & 3, t_ = (((F.bx >> 2) * 131 + 7) & (SEQ - 1)); dbg_token_task(F, l, b_, t_, (float*)(ws + WS_CTL) + 1024 + 4 * l); } }
#endif
        if (IN(P + 6)) { PHASE_BEGIN(); const bf16* W = (const bf16*)(ws + WS_WO + (size_t)l * 8 * MiB); const float* sto = ST(3 * l); float* stn = ST(3 * l + 1);
            sk_resid(F, (const bf16*)(ws + WS_R1 + R1_AO) + (size_t)MP * DM, DM, W, 1.0f, sto, LG(3 * l), LB(3 * l), stn, 1);
            pg8::Gemm g{(const bf16*)(ws + WS_R1 + R1_AO), W, MP, DM, DM}; pg8::StaticOrder S; S.init(MP, DM, F.G, F.bx);
            pg8::EpiResid E{X, 1.0f, ALPHA, sto, LG(3 * l), LB(3 * l), (float*)(ws + WS_STATP), 1}; pg8::gemm_phase<pg8::EpiResid, pg8::StaticOrder, PG8_ALIGN, PG8_SP2>(glds, g, S, E); SEAM(P + 6); }
        if (IN(P + 8)) { PHASE_BEGIN(); const bf16* W = (const bf16*)(ws + WS_WFI + (size_t)(2 * l + 1) * 44 * MiB); const float* st = ST(3 * l + 1); const float* cb = CB(l ? FM_F2L1 : FM_F2L0);
            pg8::Gemm g{X, W, MP, NFF2, DM}; pg8::StaticOrder S; S.init(MP, NFF2, F.G, F.bx); stats_finalize_local(F, S, (const float*)(ws + WS_STATP), ST(3 * l + 1)); sk_swiglu(F, W, st, cb, 1);
            pg8::EpiSwiglu E{H, st, cb, 1}; pg8::gemm_phase<pg8::EpiSwiglu, pg8::StaticOrder, PG8_ALIGN, PG8_SP2>(glds, g, S, E); SEAM(P + 8); }
        if (IN(P + 9)) { PHASE_BEGIN(); const bf16* W = (const bf16*)(ws + WS_WFO + (size_t)(2 * l + 1) * 22 * MiB); const float* sto = ST(3 * l + 1); float* stn = ST(3 * l + 2);
            sk_resid(F, H + (size_t)MP * DFF, DFF, W, 0.5f, sto, LG(3 * l + 1), LB(3 * l + 1), stn, 1); pg8::Gemm g{H, W, MP, DM, DFF}; pg8::StaticOrder S; S.init(MP, DM, F.G, F.bx);
            pg8::EpiResid E{X, 0.5f, ALPHA, sto, LG(3 * l + 1), LB(3 * l + 1), (float*)(ws + WS_STATP), 1}; pg8::gemm_phase<pg8::EpiResid, pg8::StaticOrder, PG8_ALIGN, PG8_SP2>(glds, g, S, E); SEAM(P + 9); }
        if (IN(P + 10) && l == 1) { PHASE_BEGIN(); float yss = 1.0f;
#ifdef DBG_CHECK
            { const float* da = (const float*)(ws + WS_CTL) + 1024; float r2 = 0.f; if (DBG_CHECK < 4) r2 = da[2 * (DBG_CHECK)] / fmaxf(da[2 * (DBG_CHECK) + 1], 1e-30f); else { for (int c_ = 1; c_ < 4; ++c_) r2 = fmaxf(r2, da[2 * c_] / fmaxf(da[2 * c_ + 1], 1e-30f)); } yss = 1.0f + 10.0f * sqrtf(r2); }
#endif
            ln_phase(F, LG(5), LB(5), F.out, yss); }
#undef ST
#undef CB
#undef LG
#undef LB
    }
#undef IN
#undef SEAM
}

extern "C" void kernel_launch(void* const* d_in, const int* in_sizes, int n_in, void* d_out, int out_size, void* d_ws, size_t ws_size, hipStream_t stream) {
    static int grid = 0;
    if (grid == 0) {
        if (n_in != 21 || (size_t)out_size != O_END || ws_size < WS_END) { fprintf(stderr, "kernel_launch: shape mismatch: n_in %d out %d (want %zu) ws %zu (want >= %zu); nothing launched\n", n_in, out_size, (size_t)O_END, ws_size, (size_t)WS_END); grid = -1; return; }
        int dev = 0, cus = 0, per_cu = 0;
        if (hipGetDevice(&dev) != hipSuccess || hipDeviceGetAttribute(&cus, hipDeviceAttributeMultiprocessorCount, dev) != hipSuccess) { fprintf(stderr, "kernel_launch: device query failed\n"); grid = -1; return; }
        if (hipFuncSetAttribute((const void*)fwd_kernel, hipFuncAttributeMaxDynamicSharedMemorySize, LDS_BYTES) != hipSuccess) { fprintf(stderr, "kernel_launch: hipFuncSetAttribute failed\n"); grid = -1; return; }
        if (hipOccupancyMaxActiveBlocksPerMultiprocessor(&per_cu, (const void*)fwd_kernel, NWAVES * 64, LDS_BYTES) != hipSuccess || per_cu < 1) fprintf(stderr, "kernel_launch: occupancy query reports %d\n", per_cu);
        (void)hipGetLastError();
        grid = cus;
    }
    if (grid < 0) return;
    if (hipMemsetAsync((char*)d_ws + WS_CTL, 0, CTL_ZERO_BYTES, stream) != hipSuccess) { fprintf(stderr, "kernel_launch: memset failed\n"); return; }
    Params a{};
    for (int i = 0; i < 21; ++i) a.in[i] = (const float*)d_in[i];
    a.out = (float*)d_out; a.ws = (unsigned char*)d_ws;
#ifndef MK_CUTS
    a.ph_lo = 0; a.ph_hi = PH_END;
    hipLaunchKernelGGL(fwd_kernel, dim3(grid), dim3(NWAVES * 64), LDS_BYTES, stream, a);
#else
    for (int p = 0; p < PH_END; ++p) { a.ph_lo = p; a.ph_hi = p + 1; hipLaunchKernelGGL(fwd_kernel, dim3(grid), dim3(NWAVES * 64), LDS_BYTES, stream, a); }
#endif
    const hipError_t le = hipPeekAtLastError();
    if (le != hipSuccess) fprintf(stderr, "kernel_launch: launch failed: %s\n", hipGetErrorName(le));
}
```
